# Optimizing an MI355X kernel written in HIP

```python
import jax, jax.numpy as jnp
from jax import lax
import numpy as np

D_MODEL = 1024
BATCH = 4
SEQ = 4096
DEPTH = 4

CHUNK = 64
LEFT_CHUNKS = 8
BAND = LEFT_CHUNKS + 1
HEAD_DIM = 64
ATTN_WIDTH = D_MODEL // 2
N_HEADS = ATTN_WIDTH // HEAD_DIM
MAX_REL = 2 * CHUNK
POOL_WINDOWS = (2, 4, 8, 16)
POOL_WIDTH = D_MODEL - ATTN_WIDTH
POOL_GROUP = POOL_WIDTH // len(POOL_WINDOWS)
MIX_WIDTH = ATTN_WIDTH + POOL_WIDTH
IN_WIDTH = 3 * ATTN_WIDTH + POOL_WIDTH
N_EXPERTS = 32
TOP_K = 4
D_EXPERT = D_MODEL
SWIGLU_ALPHA = 1.702
SWIGLU_LIMIT = 7.0
MOE_BLOCK = 256
NORM_EPS = 1e-6
MASK_VALUE = -1e30

kernel_name = "hymba_chunk_relbias_pool_moe_adaln"


def rmsnorm(x, g):
    xf = x.astype(jnp.float32)
    y = xf * lax.rsqrt(jnp.mean(xf * xf, axis=-1, keepdims=True) + NORM_EPS)
    return (y * g.astype(jnp.float32)).astype(x.dtype)


def chunk_rel_attention(q, k, v, q_g, k_g, rel_bias):
    B, S, _ = q.shape
    NC = S // CHUNK

    def heads(t):
        return t.reshape(B, NC, CHUNK, N_HEADS, HEAD_DIM)

    qc = rmsnorm(heads(q), q_g)
    kc = rmsnorm(heads(k), k_g)
    vc = heads(v)
    pad = ((0, 0), (LEFT_CHUNKS, 0), (0, 0), (0, 0), (0, 0))

    def band(t):
        tp = jnp.pad(t, pad)
        return jnp.concatenate([tp[:, j:j + NC] for j in range(BAND)], axis=2)

    kb, vb = band(kc), band(vc)
    s = jnp.einsum("bnqhd,bnkhd->bnhqk", qc, kb).astype(jnp.float32) * (HEAD_DIM ** -0.5)
    q_in = jnp.arange(CHUNK)
    k_in = jnp.arange(BAND * CHUNK)
    rel = k_in[None, :] - LEFT_CHUNKS * CHUNK - q_in[:, None]
    bias = rel_bias[:, jnp.clip(rel, -MAX_REL, MAX_REL) + MAX_REL]
    key_chunk = jnp.arange(NC)[:, None] - LEFT_CHUNKS + k_in[None, :] // CHUNK
    valid = key_chunk >= 0
    s = s + bias.astype(jnp.float32)[None, None]
    s = jnp.where(valid[None, :, None, None, :], s, MASK_VALUE)
    p = jax.nn.softmax(s, axis=-1).astype(v.dtype)
    o = jnp.einsum("bnhqk,bnkhd->bnqhd", p, vb)
    return o.reshape(B, S, ATTN_WIDTH)


def multiscale_pool(u, pool_w, pool_b, pool_scale):
    B, S, _ = u.shape
    uf = u.astype(jnp.float32)
    cs0 = jnp.pad(jnp.cumsum(uf, axis=1), ((0, 0), (1, 0), (0, 0)))
    t = jnp.arange(S)
    outs = []
    for gi, w in enumerate(POOL_WINDOWS):
        sl = slice(gi * POOL_GROUP, (gi + 1) * POOL_GROUP)
        csg = cs0[..., sl]
        hi = csg[:, 1:]
        lo = jnp.pad(csg[:, :S + 1 - w], ((0, 0), (w - 1, 0), (0, 0)))
        count = jnp.minimum(t + 1, w).astype(jnp.float32)[None, :, None]
        d = (hi - lo) / count - uf[..., sl]
        outs.append(d.astype(u.dtype) @ pool_w[gi] + pool_b[sl])
    return jnp.concatenate(outs, axis=-1) * pool_scale


def clamped_swiglu(gu):
    glu, lin = jnp.split(gu, 2, axis=-1)
    glu = jnp.minimum(glu, SWIGLU_LIMIT)
    lin = jnp.clip(lin, -SWIGLU_LIMIT, SWIGLU_LIMIT)
    return glu * jax.nn.sigmoid(SWIGLU_ALPHA * glu) * (lin + 1.0)


def moe(h, router_w, router_b, w1, b1, w2, b2):
    B, S, D = h.shape
    N = B * S
    NK = N * TOP_K
    xf = h.reshape(N, D)
    logits = (xf @ router_w + router_b).astype(jnp.float32)
    top_vals, top_idx = lax.top_k(logits, TOP_K)
    gates = jax.nn.softmax(top_vals, axis=-1)
    flat_e = top_idx.reshape(NK)
    flat_tok = jnp.repeat(jnp.arange(N, dtype=jnp.int32), TOP_K)
    flat_g = gates.reshape(NK)
    order = jnp.argsort(flat_e)
    se = flat_e[order]
    counts = jnp.bincount(flat_e, length=N_EXPERTS)
    padded = (counts + MOE_BLOCK - 1) // MOE_BLOCK * MOE_BLOCK
    start = jnp.cumsum(counts) - counts
    pend = jnp.cumsum(padded)
    pstart = pend - padded
    dest = pstart[se] + (jnp.arange(NK) - start[se])
    P = NK + N_EXPERTS * MOE_BLOCK
    tok_buf = jnp.zeros((P,), jnp.int32).at[dest].set(flat_tok[order])
    gate_buf = jnp.zeros((P,), jnp.float32).at[dest].set(flat_g[order])
    n_blocks = P // MOE_BLOCK
    block_e = jnp.minimum(
        jnp.searchsorted(pend, jnp.arange(n_blocks) * MOE_BLOCK, side="right"), N_EXPERTS - 1)

    def expert_block(args):
        tok, e = args
        xb = xf[tok]
        a = clamped_swiglu(xb @ w1[e] + b1[e])
        return a @ w2[e] + b2[e]

    out_buf = lax.map(expert_block, (tok_buf.reshape(n_blocks, MOE_BLOCK), block_e))
    y = jnp.zeros((N, D), jnp.float32).at[tok_buf].add(
        out_buf.reshape(P, D).astype(jnp.float32) * gate_buf[:, None])
    return y.reshape(B, S, D).astype(h.dtype)


def setup_inputs(seed: int = 0) -> dict:
    key = jax.random.key(seed)
    ks = jax.random.split(key, 20)
    L, D, E, F = DEPTH, D_MODEL, N_EXPERTS, D_EXPERT
    G = len(POOL_WINDOWS)

    def nrm(k, shape, s):
        return s * jax.random.normal(k, shape, jnp.float32)

    return {
        "x": nrm(ks[0], (BATCH, SEQ, D), 1.0),
        "c": nrm(ks[1], (BATCH, D), 1.0),
        "norm1_g": 1.0 + nrm(ks[2], (L, D), 0.05),
        "w_mod": nrm(ks[3], (L, D, 6 * D), 0.5 * D ** -0.5),
        "b_mod": nrm(ks[4], (L, 6 * D), 0.02),
        "w_in": nrm(ks[5], (L, D, IN_WIDTH), D ** -0.5),
        "q_norm_g": 1.0 + nrm(ks[6], (L, HEAD_DIM), 0.05),
        "k_norm_g": 1.0 + nrm(ks[7], (L, HEAD_DIM), 0.05),
        "rel_bias": nrm(ks[8], (L, N_HEADS, 2 * MAX_REL + 1), 0.5),
        "pool_w": nrm(ks[9], (L, G, POOL_GROUP, POOL_GROUP), POOL_GROUP ** -0.5),
        "pool_b": nrm(ks[10], (L, POOL_WIDTH), 0.02),
        "pool_scale": 1.0 + nrm(ks[11], (L, POOL_WIDTH), 0.05),
        "w_out": nrm(ks[12], (L, MIX_WIDTH, D), MIX_WIDTH ** -0.5),
        "norm2_g": 1.0 + nrm(ks[13], (L, D), 0.05),
        "router_w": nrm(ks[14], (L, D, E), D ** -0.5),
        "router_b": nrm(ks[15], (L, E), 0.01),
        "exp_w1": nrm(ks[16], (L, E, D, 2 * F), D ** -0.5),
        "exp_b1": nrm(ks[17], (L, E, 2 * F), 0.02),
        "exp_w2": nrm(ks[18], (L, E, F, D), F ** -0.5),
        "exp_b2": nrm(ks[19], (L, E, D), 0.02),
    }


def reference(x, c, norm1_g, w_mod, b_mod, w_in, q_norm_g, k_norm_g, rel_bias, pool_w, pool_b,
              pool_scale, w_out, norm2_g, router_w, router_b, exp_w1, exp_b1, exp_w2, exp_b2):
    cond = jax.nn.silu(c)
    for l in range(DEPTH):
        mod = cond @ w_mod[l] + b_mod[l]
        sh1, sc1, g1, sh2, sc2, g2 = [m[:, None, :] for m in jnp.split(mod, 6, axis=-1)]
        h = rmsnorm(x, norm1_g[l]) * (1.0 + sc1) + sh1
        z = h @ w_in[l]
        q, k, v, u = jnp.split(z, [ATTN_WIDTH, 2 * ATTN_WIDTH, 3 * ATTN_WIDTH], axis=-1)
        attn = chunk_rel_attention(q, k, v, q_norm_g[l], k_norm_g[l], rel_bias[l])
        pooled = multiscale_pool(u, pool_w[l], pool_b[l], pool_scale[l])
        x = x + g1 * (jnp.concatenate([attn, pooled], axis=-1) @ w_out[l])
        h = rmsnorm(x, norm2_g[l]) * (1.0 + sc2) + sh2
        x = x + g2 * moe(h, router_w[l], router_b[l], exp_w1[l], exp_b1[l], exp_w2[l], exp_b2[l])
    return x
```

```cpp
#include <hip/hip_runtime.h>
#include <cstdio>
#include <cstdint>

#ifndef MK_ONE_LAUNCH
#define MK_ONE_LAUNCH 0
#endif

#define GAS __attribute__((address_space(1)))
#define LAS __attribute__((address_space(3)))
typedef unsigned short bf16;
typedef unsigned u32x4 __attribute__((ext_vector_type(4)));
typedef unsigned u32x2 __attribute__((ext_vector_type(2)));
typedef float f32x4 __attribute__((ext_vector_type(4)));
typedef float f32x2 __attribute__((ext_vector_type(2)));
typedef short bf16x8 __attribute__((ext_vector_type(8)));
typedef GAS unsigned gu32;

constexpr int NB = 4, SEQ = 4096, D = 1024, M = NB * SEQ, DEPTH = 4;
constexpr int CHUNK = 64, NCH = SEQ / CHUNK, LEFTC = 8;
constexpr int NH = 8, HD = 64, AW = 512, PGRP = 128, INW = 2048;
constexpr int NE = 32, TOPK = 4, FE = 1024;
constexpr int MAXT = 288;
constexpr int MAXU = 9;
constexpr float EPS = 1e-6f;
constexpr float LOG2E = 1.4426950408889634f;
constexpr int MODW = 6 * D;

constexpr size_t MiB = 1u << 20;
constexpr size_t WS_CTL = 0, CTL_ZERO_BYTES = 1 * MiB;
constexpr size_t WS_MOD = 1 * MiB;
constexpr size_t WS_RWT = 2 * MiB;
constexpr size_t WS_GATE = 3 * MiB;
constexpr size_t WS_SLOT = 3 * MiB + 512 * 1024;
constexpr size_t WS_TOK = 4 * MiB;
constexpr size_t WS_WIN = 8 * MiB;
constexpr size_t WS_WOUT = 24 * MiB;
constexpr size_t WS_XN = 32 * MiB;
constexpr size_t WS_QKVU = 64 * MiB;
constexpr size_t WS_MIX = 128 * MiB;
constexpr size_t WS_H = 160 * MiB;
constexpr size_t WS_OB = 304 * MiB;
constexpr size_t WS_W1 = 448 * MiB;
constexpr size_t WS_W2 = 960 * MiB;
constexpr size_t WS_END = 1216 * MiB;
constexpr int CW_TMO = 0, CW_CODE = 1;
constexpr int CW_BAR = 4096;
constexpr int CW_CNT = 16384;

constexpr int RING_OFF = 0, RING_BYTES = 131072;
constexpr int LDSCTL_OFF = RING_BYTES;
constexpr int XTR_OFF = RING_BYTES + 512;
constexpr int LDS_BYTES = 147456;
constexpr int XTR_BYTES = LDS_BYTES - XTR_OFF;

#define RLX_AGENT __ATOMIC_RELAXED, __HIP_MEMORY_SCOPE_AGENT
#define LDS_WAIT() asm volatile("s_waitcnt lgkmcnt(0)" ::: "memory")
#define VM_WAIT() asm volatile("s_waitcnt vmcnt(0)" ::: "memory")
__device__ __forceinline__ unsigned f2bf(float f) { unsigned u = __builtin_bit_cast(unsigned, f); return (u + 0x7fffu + ((u >> 16) & 1u)) >> 16; }
__device__ __forceinline__ unsigned pk2(float lo, float hi) { return f2bf(lo) | (f2bf(hi) << 16); }
__device__ __forceinline__ unsigned cvt_pk_bf16(float lo, float hi) { unsigned r; asm volatile("v_cvt_pk_bf16_f32 %0, %1, %2" : "=v"(r) : "v"(lo), "v"(hi)); return r; }
__device__ __forceinline__ float bflo(unsigned u) { return __builtin_bit_cast(float, u << 16); }
__device__ __forceinline__ float bfhi(unsigned u) { return __builtin_bit_cast(float, u & 0xffff0000u); }
__device__ __forceinline__ float wave_sum(float v) {
#pragma unroll
    for (int o = 1; o < 64; o <<= 1) v += __shfl_xor(v, o);
    return v;
}

#define XB_TMO      128
#define XB_XCNT(j)  (256  + 64 * (j))
#define XB_XSUB(j)  (1280 + 64 * (j))
#define XB_XGEN(j)  (2304 + 64 * (j))
#define XB_TOP      3328
#define XB_TOPGEN   3392
#define XCD_BAR_WORDS 3456
#define XB_SPIN_CAP (1u << 18)
__device__ __forceinline__ unsigned xb_ld(unsigned* p)              { return __hip_atomic_load(p, __ATOMIC_RELAXED, __HIP_MEMORY_SCOPE_AGENT); }
__device__ __forceinline__ unsigned xb_add(unsigned* p, unsigned v) { return __hip_atomic_fetch_add(p, v, __ATOMIC_RELAXED, __HIP_MEMORY_SCOPE_AGENT); }
__device__ __forceinline__ unsigned xb_xcc_id() { return (unsigned)__builtin_amdgcn_s_getreg((3 << 11) | 20) & 0xFu; }
#define XB_SPIN(cond, bar) do { unsigned _sp = 0; while (cond) { __builtin_amdgcn_s_sleep(1); \
    if ((++_sp & 255u) == 0u) { if (xb_ld(&(bar)[XB_TMO])) break; if (_sp > XB_SPIN_CAP) { atomicAdd(&(bar)[XB_TMO], 1u); break; } } } } while (0)
struct XcdBarrier { unsigned* bar; unsigned x; volatile LAS unsigned* st; };
__device__ __forceinline__ XcdBarrier xcd_barrier_post(unsigned* bar, volatile LAS unsigned* st) {
    XcdBarrier b; b.bar = bar; b.x = xb_xcc_id(); b.st = st;
    if (threadIdx.x == 0) (void)xb_add(&bar[XB_XCNT(b.x)], 1u);
    return b;
}
__device__ __forceinline__ void xcd_barrier_complete(unsigned* bar, unsigned x, unsigned& nloc, unsigned& nx) {
    const unsigned G = gridDim.x * gridDim.y * gridDim.z;
    unsigned sum, cnt, mine, sp = 0u;
    for (;;) {
        sum = 0u; cnt = 0u; mine = 0u;
#pragma unroll
        for (unsigned j = 0; j < 16; ++j) { const unsigned c = xb_ld(&bar[XB_XCNT(j)]); sum += c; cnt += (c > 0u) ? 1u : 0u; mine = (j == x) ? c : mine; }
        if (sum == G) break;
        __builtin_amdgcn_s_sleep(1);
        if ((++sp & 255u) == 0u) { if (xb_ld(&bar[XB_TMO])) break; if (sp > XB_SPIN_CAP) { atomicAdd(&bar[XB_TMO], 1u); break; } }
    }
    nloc = mine > 0u ? mine : 1u; nx = cnt > 0u ? cnt : 1u;
}
__device__ __forceinline__ void xcd_barrier(const XcdBarrier& b) {
    asm volatile("s_waitcnt vmcnt(0)" ::: "memory");
    __syncthreads();
    if (threadIdx.x == 0) {
        unsigned* bar = b.bar;
        __builtin_amdgcn_s_waitcnt(0);
        unsigned nloc = b.st[0], nx = b.st[1];
        if (nloc == 0u) { xcd_barrier_complete(bar, b.x, nloc, nx); b.st[0] = nloc; b.st[1] = nx; }
        const unsigned old = xb_add(&bar[XB_XSUB(b.x)], 1u);
        const unsigned gen = old / nloc;
        if (old + 1u == (gen + 1u) * nloc) {
            __builtin_amdgcn_fence(__ATOMIC_RELEASE, "agent");
            asm volatile("s_waitcnt vmcnt(0)" ::: "memory");
            const unsigned og = xb_add(&bar[XB_TOP], 1u);
            const unsigned tg = og / nx;
            if (og + 1u == (tg + 1u) * nx) xb_add(&bar[XB_TOPGEN], 1u);
            else XB_SPIN(xb_ld(&bar[XB_TOPGEN]) == tg, bar);
            __builtin_amdgcn_fence(__ATOMIC_ACQUIRE, "agent");
            xb_add(&bar[XB_XGEN(b.x)], 1u);
            asm volatile("s_waitcnt vmcnt(0)" ::: "memory");
        } else {
            XB_SPIN(xb_ld(&bar[XB_XGEN(b.x)]) == gen, bar);
            __builtin_amdgcn_fence(__ATOMIC_ACQUIRE, "agent");
            asm volatile("s_waitcnt vmcnt(0)" ::: "memory");
        }
    }
    __syncthreads();
}

namespace pg8 {
constexpr int BM = 256, BK = 64, HALF = 128, HTB = HALF * BK * 2, STAGE_BYTES = 8 * HTB, NXCD = 8, WGM = 8, KD = 1024;
constexpr size_t KSTEP = (size_t)BK * 2, HSTEP = (size_t)HALF * KD * 2, TSTEP = 2 * HSTEP;
__host__ __device__ __forceinline__ int lds_byte(int r, int c) { const int st = (r >> 4) * 2 + (c >> 5), rr = r & 15, cc = c & 31, ob = rr * 64 + cc * 2; return st * 1024 + (ob ^ (((ob >> 9) & 1) << 5)); }
__host__ __device__ __forceinline__ void stage_rc(int b, int& R, int& C) { const int st = b / 1024, sb = b % 1024, swz = sb ^ (((sb >> 9) & 1) << 5); R = (st >> 1) * 16 + swz / 64; C = (st & 1) * 32 + (swz % 64) / 2; }
__host__ __device__ __forceinline__ int perm32(int rho) { const int n = rho >> 4, i = rho & 15; return 8 * (i >> 2) + 4 * n + (i & 3); }

struct GUnit { const char* A; const char* B; int row0; int pn; int e; int li; };

struct DenseOrder {
    int nM, nN, nwg, G, c; const char* A; const char* B;
    __device__ __forceinline__ void init(int M_, int N_, int G_, int c_, const void* A_, const void* B_) { nM = M_ / BM; nN = N_ / BM; nwg = nM * nN; G = G_; c = c_; A = (const char*)A_; B = (const char*)B_; }
    __device__ __forceinline__ bool next(int i, GUnit& u) const {
        const long L = (long)i * G + c; if (L >= nwg) return false;
        int wgid = (int)L; { const int q = nwg / NXCD, r = nwg % NXCD, xcd = wgid % NXCD, off = wgid / NXCD; wgid = (xcd < r ? xcd * (q + 1) : r * (q + 1) + (xcd - r) * q) + off; }
        const int nig = WGM * nN, gid = wgid / nig, fm = gid * WGM, gsz = (nM - fm) < WGM ? (nM - fm) : WGM;
        const int pm = fm + ((wgid % nig) % gsz), pn = (wgid % nig) / gsz;
        u.A = A + (size_t)pm * TSTEP; u.B = B + (size_t)pn * TSTEP; u.row0 = pm * BM; u.pn = pn; u.e = 0; u.li = i; return true;
    }
    __device__ __forceinline__ unsigned tokoff(int, int) const { return 0u; }
};
struct MoeOrder {
    const LAS int* tile_e; const LAS unsigned* toff;
    int T, vcu, G, ncol, rpb; const char* A; const char* B; size_t estride; bool gather;
    __device__ __forceinline__ bool next(int i, GUnit& u) const {
        const int uu = vcu + i * G; if (uu >= T * ncol) return false;
        const int blk = uu >> 5, j = uu & 31; int tib = T - blk * rpb; tib = tib > rpb ? rpb : tib;
        const int tile = blk * rpb + j % tib, pn = j / tib;
        const int e = __builtin_amdgcn_readfirstlane(tile_e[tile]);
        u.row0 = tile * BM; u.pn = pn; u.e = e; u.li = i;
        u.A = gather ? A : A + (size_t)tile * TSTEP; u.B = B + (size_t)e * estride + (size_t)pn * TSTEP; return true;
    }
    __device__ __forceinline__ unsigned tokoff(int li, int r) const { return toff[li * 256 + r]; }
};

typedef f32x4 Acc[2][2][4][2];

struct EpiWin {
    static constexpr bool PERM = true;
    bf16* O; const float* qg; const float* kg;
    __device__ __forceinline__ void operator()(const Acc& acc, const GUnit& u, int wr, int wc, int fr, int fq) const {
        const int kind = u.pn >> 1;
        const int col0 = u.pn * 256 + 64 * wc + 8 * fq;
        f32x4 gv[2][2];
#pragma unroll
        for (int bj = 0; bj < 2; ++bj)
#pragma unroll
            for (int n = 0; n < 2; ++n) {
                const int d = 32 * bj + 8 * fq + 4 * n;
                if (kind == 0) gv[bj][n] = *(const f32x4*)(qg + d) * (0.125f * LOG2E);
                else if (kind == 1) gv[bj][n] = *(const f32x4*)(kg + d);
                else gv[bj][n] = (f32x4){1.f, 1.f, 1.f, 1.f};
            }
#pragma unroll
        for (int ai = 0; ai < 2; ++ai)
#pragma unroll
            for (int m = 0; m < 4; ++m) {
                const int row = u.row0 + ai * HALF + wr * 64 + m * 16 + fr;
                float rstd = 1.f;
                if (kind < 2) {
                    float ss = 0.f;
#pragma unroll
                    for (int bj = 0; bj < 2; ++bj)
#pragma unroll
                        for (int n = 0; n < 2; ++n) { const f32x4 x = acc[ai][bj][m][n]; ss += (x[0] * x[0] + x[1] * x[1]) + (x[2] * x[2] + x[3] * x[3]); }
                    ss += __shfl_xor(ss, 16); ss += __shfl_xor(ss, 32);
                    rstd = __builtin_amdgcn_rsqf(ss * (1.f / 64.f) + EPS);
                }
                bf16* rowp = O + (size_t)row * INW + col0;
#pragma unroll
                for (int bj = 0; bj < 2; ++bj) {
                    const f32x4 v0 = acc[ai][bj][m][0] * rstd * gv[bj][0], v1 = acc[ai][bj][m][1] * rstd * gv[bj][1];
                    u32x4 w; w.x = cvt_pk_bf16(v0[0], v0[1]); w.y = cvt_pk_bf16(v0[2], v0[3]); w.z = cvt_pk_bf16(v1[0], v1[1]); w.w = cvt_pk_bf16(v1[2], v1[3]);
                    *(u32x4*)(rowp + 32 * bj) = w;
                }
            }
    }
};
struct EpiWout {
    static constexpr bool PERM = false;
    const float* xin; float* xout; const float* g1;
    __device__ __forceinline__ void operator()(const Acc& acc, const GUnit& u, int wr, int wc, int fr, int fq) const {
        const int b = u.row0 / SEQ; const int col0 = u.pn * BM + wc * 32 + 4 * fq;
        f32x4 gv[2][2];
#pragma unroll
        for (int bj = 0; bj < 2; ++bj)
#pragma unroll
            for (int n = 0; n < 2; ++n) gv[bj][n] = *(const f32x4*)(g1 + (size_t)b * MODW + col0 + bj * HALF + n * 16);
#pragma unroll
        for (int ai = 0; ai < 2; ++ai)
#pragma unroll
            for (int m = 0; m < 4; ++m) {
                const size_t off = (size_t)(u.row0 + ai * HALF + wr * 64 + m * 16 + fr) * D + col0;
#pragma unroll
                for (int bj = 0; bj < 2; ++bj)
#pragma unroll
                    for (int n = 0; n < 2; ++n) { const f32x4 xv = *(const f32x4*)(xin + off + bj * HALF + n * 16); *(f32x4*)(xout + off + bj * HALF + n * 16) = xv + gv[bj][n] * acc[ai][bj][m][n]; }
                if (m & 1) asm volatile("" ::: "memory");
            }
    }
};
struct EpiSwiglu {
    static constexpr bool PERM = true;
    bf16* H; const float* b1;
    __device__ __forceinline__ void operator()(const Acc& acc, const GUnit& u, int wr, int wc, int fr, int fq) const {
        const int j0 = u.pn * 128 + wc * 32 + 8 * fq; const float* be = b1 + (size_t)u.e * 2048 + j0;
        f32x4 bg[2], bl[2];
#pragma unroll
        for (int n = 0; n < 2; ++n) { bg[n] = *(const f32x4*)(be + 4 * n); bl[n] = *(const f32x4*)(be + 1024 + 4 * n); }
#pragma unroll
        for (int ai = 0; ai < 2; ++ai)
#pragma unroll
            for (int m = 0; m < 4; ++m) {
                bf16* rowp = H + (size_t)(u.row0 + ai * HALF + wr * 64 + m * 16 + fr) * FE + j0;
                float o[8];
#pragma unroll
                for (int n = 0; n < 2; ++n)
#pragma unroll
                    for (int i = 0; i < 4; ++i) {
                        float g = acc[ai][0][m][n][i] + bg[n][i], l = acc[ai][1][m][n][i] + bl[n][i];
                        g = fminf(g, 7.0f); l = fminf(fmaxf(l, -7.0f), 7.0f);
                        const float sg = __builtin_amdgcn_rcpf(1.0f + __builtin_amdgcn_exp2f(-1.702f * LOG2E * g));
                        o[4 * n + i] = g * sg * (l + 1.0f);
                    }
                u32x4 w; w.x = cvt_pk_bf16(o[0], o[1]); w.y = cvt_pk_bf16(o[2], o[3]); w.z = cvt_pk_bf16(o[4], o[5]); w.w = cvt_pk_bf16(o[6], o[7]);
                *(u32x4*)rowp = w;
            }
    }
};
struct EpiOB {
    static constexpr bool PERM = true;
    bf16* O; const float* b2;
    __device__ __forceinline__ void operator()(const Acc& acc, const GUnit& u, int wr, int wc, int fr, int fq) const {
        const int col0 = u.pn * BM + wc * 32 + 8 * fq; const float* be = b2 + (size_t)u.e * D + col0;
        f32x4 bv[2][2];
#pragma unroll
        for (int bj = 0; bj < 2; ++bj)
#pragma unroll
            for (int n = 0; n < 2; ++n) bv[bj][n] = *(const f32x4*)(be + bj * HALF + 4 * n);
#pragma unroll
        for (int ai = 0; ai < 2; ++ai)
#pragma unroll
            for (int m = 0; m < 4; ++m) {
                bf16* rowp = O + (size_t)(u.row0 + ai * HALF + wr * 64 + m * 16 + fr) * D + col0;
#pragma unroll
                for (int bj = 0; bj < 2; ++bj) {
                    const f32x4 v0 = acc[ai][bj][m][0] + bv[bj][0], v1 = acc[ai][bj][m][1] + bv[bj][1];
                    u32x4 w; w.x = cvt_pk_bf16(v0[0], v0[1]); w.y = cvt_pk_bf16(v0[2], v0[3]); w.z = cvt_pk_bf16(v1[0], v1[1]); w.w = cvt_pk_bf16(v1[2], v1[3]);
                    *(u32x4*)(rowp + bj * HALF) = w;
                }
            }
    }
};

template <class Epi, class Sched, bool GATHER>
__device__ __forceinline__ void gemm_phase(LAS unsigned char* lds, const Sched& S, const Epi& E) {
    int tid_ = threadIdx.x; asm volatile("" : "+v"(tid_));
    const int tid = tid_, wid = __builtin_amdgcn_readfirstlane(tid >> 6), lane = tid & 63, wr = wid >> 2, wc = wid & 3, fr = lane & 15, fq = lane >> 4;
    constexpr int K = KD, nt = K / BK;
    unsigned voffA[2], voffB[2]; int RA[2]; unsigned CA[2];
#pragma unroll
    for (int i = 0; i < 2; ++i) { int R, C; stage_rc(tid * 16 + i * 8192, R, C); const int Rb = Epi::PERM ? ((R & ~31) + perm32(R & 31)) : R;
        voffA[i] = (unsigned)(R * K + C) * 2u; voffB[i] = (unsigned)(Rb * K + C) * 2u; RA[i] = R; CA[i] = (unsigned)C * 2u; }
    constexpr size_t kstep = KSTEP, hstep = HSTEP;
    const unsigned ldsw = (unsigned)wid * 1024u;
    const int aoff = lds_byte(wr * 64 + fr, fq * 8), boff = lds_byte(wc * 32 + fr, fq * 8);
#define PG8_SA(b, h) (((b) * 2 + (h)) * HTB)
#define PG8_SB(b, h) ((4 + (b) * 2 + (h)) * HTB)
#define PG8_STAGE(bufoff, gbase, voff) do { _Pragma("unroll") for (int _i = 0; _i < 2; ++_i) \
        __builtin_amdgcn_global_load_lds((const unsigned*)((const char*)(gbase) + (voff)[_i]), (LAS unsigned*)(lds + (bufoff) + ldsw + _i * 8192), 16, 0, 0); } while (0)
#define PG8_STAGE_A(bufoff, base, h, V) do { if constexpr (GATHER) { PG8_STAGE(bufoff, base, (V)[h]); } else { PG8_STAGE(bufoff, (base) + (h) * hstep, voffA); } } while (0)
#define PG8_LDA(dst, b, h) do { _Pragma("unroll") for (int m = 0; m < 4; ++m) _Pragma("unroll") for (int k = 0; k < 2; ++k) dst[m][k] = *(const LAS bf16x8*)(lds + PG8_SA(b, h) + aoff + m * 2048 + k * 1024); } while (0)
#define PG8_LDB(dst, b, h) do { _Pragma("unroll") for (int n = 0; n < 2; ++n) _Pragma("unroll") for (int k = 0; k < 2; ++k) dst[n][k] = *(const LAS bf16x8*)(lds + PG8_SB(b, h) + boff + n * 2048 + k * 1024); } while (0)
#define PG8_MMA(ai, bj, At, Bt) do { __builtin_amdgcn_s_setprio(1); _Pragma("unroll") for (int m = 0; m < 4; ++m) _Pragma("unroll") for (int n = 0; n < 2; ++n) _Pragma("unroll") for (int k = 0; k < 2; ++k) \
        acc[ai][bj][m][n] = __builtin_amdgcn_mfma_f32_16x16x32_bf16(Bt[n][k], At[m][k], acc[ai][bj][m][n], 0, 0, 0); __builtin_amdgcn_s_setprio(0); } while (0)
#define PG8_WAIT_V(n) asm volatile("s_waitcnt vmcnt(" #n ")" ::: "memory")
#define PG8_WAIT_L(n) asm volatile("s_waitcnt lgkmcnt(" #n ")" ::: "memory")
#define PG8_BAR __builtin_amdgcn_s_barrier()
#define PG8_SCHED __builtin_amdgcn_sched_barrier(0)
#define PG8_AOFF(V, U) do { if constexpr (GATHER) { _Pragma("unroll") for (int _h = 0; _h < 2; ++_h) _Pragma("unroll") for (int _i = 0; _i < 2; ++_i) (V)[_h][_i] = S.tokoff((U).li, _h * HALF + RA[_i]) + CA[_i]; } } while (0)
    GUnit cur, nxt; int ui = 0;
    if (!S.next(0, cur)) return;
    Acc acc;
#pragma unroll
    for (int a = 0; a < 2; ++a)
#pragma unroll
        for (int b = 0; b < 2; ++b)
#pragma unroll
            for (int m = 0; m < 4; ++m)
#pragma unroll
                for (int n = 0; n < 2; ++n) acc[a][b][m][n] = (f32x4){0.f, 0.f, 0.f, 0.f};
    bf16x8 At[4][2], B0[2][2], B1[2][2];
    unsigned va[2][2] = {{0u, 0u}, {0u, 0u}};
    const char* cA = cur.A; const char* cB = cur.B;
    PG8_AOFF(va, cur);
    PG8_STAGE(PG8_SB(0, 0), cB, voffB); PG8_STAGE(PG8_SB(0, 1), cB + hstep, voffB); PG8_STAGE_A(PG8_SA(0, 0), cA, 0, va); PG8_STAGE_A(PG8_SA(0, 1), cA, 1, va);
    if (wr == 1) PG8_BAR;
    PG8_WAIT_V(2); PG8_BAR;
    PG8_STAGE(PG8_SB(1, 0), cB + kstep, voffB); PG8_STAGE_A(PG8_SA(1, 0), cA + kstep, 0, va); PG8_STAGE(PG8_SB(1, 1), cB + hstep + kstep, voffB);
    PG8_WAIT_V(6); PG8_BAR;
    for (;;) {
        const bool has_next = S.next(ui + 1, nxt);
        const char* nA = has_next ? nxt.A : cA; const char* nB = has_next ? nxt.B : cB;
        for (int t = 0; t < nt; t += 2) {
            const bool last = (t == nt - 2);
            const char* a1 = cA + (size_t)(t + 1) * kstep;
            const char* a2 = last ? nA : cA + (size_t)(t + 2) * kstep; const char* b2 = last ? nB : cB + (size_t)(t + 2) * kstep;
            const char* a3 = a2 + kstep; const char* b3 = b2 + kstep;
            PG8_LDB(B0, 0, 0); PG8_LDB(B1, 0, 1); PG8_SCHED; PG8_LDA(At, 0, 0); PG8_STAGE_A(PG8_SA(1, 1), a1, 1, va);
            if constexpr (GATHER) { if (last && has_next) { PG8_AOFF(va, nxt); } }
            PG8_WAIT_V(8); PG8_WAIT_L(0); PG8_BAR; PG8_MMA(0, 0, At, B0); PG8_MMA(0, 1, At, B1); PG8_BAR; PG8_SCHED;
            PG8_LDA(At, 0, 1); PG8_STAGE(PG8_SB(0, 0), b2, voffB); PG8_STAGE(PG8_SB(0, 1), b2 + hstep, voffB); PG8_STAGE_A(PG8_SA(0, 0), a2, 0, va);
            PG8_WAIT_V(8); PG8_WAIT_L(0); PG8_BAR; PG8_MMA(1, 0, At, B0); PG8_MMA(1, 1, At, B1); PG8_BAR; PG8_SCHED;
            PG8_LDB(B0, 1, 0); PG8_LDB(B1, 1, 1); PG8_SCHED; PG8_LDA(At, 1, 0); PG8_STAGE_A(PG8_SA(0, 1), a2, 1, va);
            PG8_WAIT_V(8); PG8_WAIT_L(0); PG8_BAR; PG8_MMA(0, 0, At, B0); PG8_MMA(0, 1, At, B1); PG8_BAR; PG8_SCHED;
            PG8_LDA(At, 1, 1); PG8_STAGE(PG8_SB(1, 0), b3, voffB); PG8_STAGE(PG8_SB(1, 1), b3 + hstep, voffB); PG8_STAGE_A(PG8_SA(1, 0), a3, 0, va);
            PG8_WAIT_V(8); PG8_WAIT_L(0); PG8_BAR; PG8_MMA(1, 0, At, B0); PG8_MMA(1, 1, At, B1); PG8_BAR; PG8_SCHED;
        }
        if (wr == 0) PG8_BAR;
        E(acc, cur, wr, wc, fr, fq);
        if (!has_next) break;
#pragma unroll
        for (int a = 0; a < 2; ++a)
#pragma unroll
            for (int b = 0; b < 2; ++b)
#pragma unroll
                for (int m = 0; m < 4; ++m)
#pragma unroll
                    for (int n = 0; n < 2; ++n) acc[a][b][m][n] = (f32x4){0.f, 0.f, 0.f, 0.f};
        cur = nxt; cA = nA; cB = nB; ++ui;
        if (wr == 1) PG8_BAR;
    }
    PG8_WAIT_V(0);
    PG8_BAR;
#undef PG8_SA
#undef PG8_SB
#undef PG8_STAGE
#undef PG8_STAGE_A
#undef PG8_LDA
#undef PG8_LDB
#undef PG8_MMA
#undef PG8_WAIT_V
#undef PG8_WAIT_L
#undef PG8_BAR
#undef PG8_SCHED
#undef PG8_AOFF
}
}

struct Args { const float* in[20]; float* out; unsigned char* ws; int s_lo, s_hi; };
#define P_x (A.in[0])
#define P_c (A.in[1])
#define P_norm1_g (A.in[2])
#define P_w_mod (A.in[3])
#define P_b_mod (A.in[4])
#define P_w_in (A.in[5])
#define P_q_g (A.in[6])
#define P_k_g (A.in[7])
#define P_rel_bias (A.in[8])
#define P_pool_w (A.in[9])
#define P_pool_b (A.in[10])
#define P_pool_scale (A.in[11])
#define P_w_out (A.in[12])
#define P_norm2_g (A.in[13])
#define P_router_w (A.in[14])
#define P_router_b (A.in[15])
#define P_exp_w1 (A.in[16])
#define P_exp_b1 (A.in[17])
#define P_exp_w2 (A.in[18])
#define P_exp_b2 (A.in[19])
#define P_out (A.out)
#define P_mod ((float*)(A.ws + WS_MOD))
#define P_rwT ((float*)(A.ws + WS_RWT))
#define P_gate ((float*)(A.ws + WS_GATE))
#define P_slot ((int*)(A.ws + WS_SLOT))
#define P_tok ((int*)(A.ws + WS_TOK))
#define P_WIN ((bf16*)(A.ws + WS_WIN))
#define P_WOUT ((bf16*)(A.ws + WS_WOUT))
#define P_XN ((bf16*)(A.ws + WS_XN))
#define P_QKVU ((bf16*)(A.ws + WS_QKVU))
#define P_MIX ((bf16*)(A.ws + WS_MIX))
#define P_H ((bf16*)(A.ws + WS_H))
#define P_OB ((bf16*)(A.ws + WS_OB))
#define P_W1 ((bf16*)(A.ws + WS_W1))
#define P_W2 ((bf16*)(A.ws + WS_W2))
constexpr int NWAVES = 8;
struct Frame {
    LAS unsigned char* lds;
    volatile LAS unsigned* MISC;
    gu32* ctl;
    int tid, lane, wave, vcu, G;
};

__device__ __forceinline__ void p0_mod(Frame& F, const Args& A) {
    LAS float* cond = (LAS float*)(F.lds);
    LAS float* red = (LAS float*)(F.lds + 16384);
    for (int i = F.tid; i < NB * D; i += NWAVES * 64) { const float cv = P_c[i]; cond[i] = cv / (1.f + __expf(-cv)); }
    __syncthreads();
    const int c4 = F.lane & 31, rs = F.lane >> 5;
    for (int it = F.vcu; it < DEPTH * (MODW / 128); it += F.G) {
        const int l = it / (MODW / 128), cb = it % (MODW / 128);
        f32x4 acc[4];
#pragma unroll
        for (int b = 0; b < 4; ++b) acc[b] = (f32x4){0.f, 0.f, 0.f, 0.f};
        const float* wp = P_w_mod + ((size_t)l * D + 128 * F.wave + rs) * MODW + 128 * cb + 4 * c4;
#pragma unroll 8
        for (int kk = 0; kk < 64; ++kk) {
            const f32x4 wv = *(const f32x4*)(wp + (size_t)(2 * kk) * MODW);
            const int k = 128 * F.wave + 2 * kk + rs;
#pragma unroll
            for (int b = 0; b < 4; ++b) acc[b] += cond[b * D + k] * wv;
        }
#pragma unroll
        for (int b = 0; b < 4; ++b)
#pragma unroll
            for (int i = 0; i < 4; ++i) acc[b][i] += __shfl_xor(acc[b][i], 32);
        if (rs == 0) {
#pragma unroll
            for (int b = 0; b < 4; ++b) *(LAS f32x4*)(red + (F.wave * 4 + b) * 128 + 4 * c4) = acc[b];
        }
        __syncthreads();
        { const int b = F.tid >> 7, col = F.tid & 127; float s = 0.f;
#pragma unroll
          for (int w = 0; w < 8; ++w) s += red[(w * 4 + b) * 128 + col];
          P_mod[((size_t)l * NB + b) * MODW + 128 * cb + col] = s + P_b_mod[(size_t)l * MODW + 128 * cb + col]; }
        __syncthreads();
    }
    __syncthreads();
}
__device__ __forceinline__ void tr_item(const float* W, int N, bf16* WT, int k0, int n0, int drow, LAS float* scr, int lane) {
#pragma unroll 8
    for (int i = 0; i < 32; ++i) { const int kk = 2 * i + (lane >> 5); scr[kk * 33 + (lane & 31)] = W[(size_t)(k0 + kk) * N + n0 + (lane & 31)]; }
    LDS_WAIT(); asm volatile("" ::: "memory");
    const int c = lane & 7;
#pragma unroll
    for (int j = 0; j < 4; ++j) { const int n = (lane >> 3) + 8 * j; const LAS float* s = scr + (8 * c) * 33 + n;
        u32x4 o; o.x = pk2(s[0 * 33], s[1 * 33]); o.y = pk2(s[2 * 33], s[3 * 33]); o.z = pk2(s[4 * 33], s[5 * 33]); o.w = pk2(s[6 * 33], s[7 * 33]);
        *(GAS u32x4*)(WT + (size_t)(drow + n) * 1024 + k0 + 8 * c) = o; }
    LDS_WAIT(); asm volatile("" ::: "memory");
}
__device__ __forceinline__ void p0_convert(Frame& F, const Args& A) {
    LAS float* scr = (LAS float*)(F.lds + RING_OFF + F.wave * 16384);
    const int gw = F.vcu * NWAVES + F.wave, NGW = F.G * NWAVES;
    constexpr int I_IN = DEPTH * 16 * 64, I_OUT = DEPTH * 16 * 32, I_W1 = DEPTH * NE * 16 * 64, I_W2 = DEPTH * NE * 16 * 32;
    for (int it = gw; it < I_IN + I_OUT + I_W1 + I_W2; it += NGW) {
        int r = it;
        if (r < I_IN) { const int l = r >> 10, rr = r & 1023, kb = rr >> 6, nb = rr & 63, n0 = 32 * nb, g = (n0 & 255) >> 5;
            tr_item(P_w_in + (size_t)l * D * INW, INW, P_WIN + (size_t)l * INW * D, 64 * kb, n0, (n0 & ~255) + 128 * (g & 1) + 32 * (g >> 1), scr, F.lane); continue; }
        r -= I_IN;
        if (r < I_OUT) { const int l = r >> 9, rr = r & 511, kb = rr >> 5, nb = rr & 31;
            tr_item(P_w_out + (size_t)l * D * D, D, P_WOUT + (size_t)l * D * D, 64 * kb, 32 * nb, 32 * nb, scr, F.lane); continue; }
        r -= I_OUT;
        if (r < I_W1) { const int le = r >> 10, rr = r & 1023, kb = rr >> 6, nb = rr & 63, n0 = 32 * nb, bj = n0 >> 10, jj = n0 & 1023;
            tr_item(P_exp_w1 + (size_t)le * D * 2048, 2048, P_W1 + (size_t)le * 2048 * D, 64 * kb, n0, 256 * (jj >> 7) + 128 * bj + (jj & 127), scr, F.lane); continue; }
        r -= I_W1;
        { const int le = r >> 9, rr = r & 511, kb = rr >> 5, nb = rr & 31;
            tr_item(P_exp_w2 + (size_t)le * FE * D, D, P_W2 + (size_t)le * D * FE, 64 * kb, 32 * nb, 32 * nb, scr, F.lane); }
    }
    for (int i = (F.vcu * NWAVES * 64 + F.tid); i < DEPTH * NE * D; i += F.G * NWAVES * 64) { const int l = i >> 15, e = (i >> 10) & 31, cc = i & 1023; P_rwT[i] = P_router_w[((size_t)l * D + cc) * NE + e]; }
}

__device__ __forceinline__ int moe_tables(Frame& F, int l) {
    LAS int* X = (LAS int*)(F.lds + XTR_OFF);
    __syncthreads();
    if (F.tid < NE) X[F.tid] = (int)__hip_atomic_load(F.ctl + CW_CNT + 64 * l + F.tid, RLX_AGENT);
    __syncthreads();
    if (F.tid == 0) { int t = 0; for (int e = 0; e < NE; ++e) { X[32 + e] = t; t += (X[e] + 255) >> 8; } X[32 + NE] = t; X[66] = t; }
    __syncthreads();
    if (F.tid < NE) { const int t0 = X[32 + F.tid], t1 = X[33 + F.tid]; for (int t = t0; t < t1; ++t) X[128 + t] = F.tid; }
    __syncthreads();
    return X[66];
}

template <bool COMBINE, bool NORM>
__device__ __forceinline__ void phase_cn(Frame& F, const Args& A, int l) {
    LAS int* X = (LAS int*)(F.lds + XTR_OFF);
    if (COMBINE) (void)moe_tables(F, l - 1);
    const float* xin = (COMBINE || l > 0) ? P_out : P_x;
    for (int rb = F.vcu * NWAVES + F.wave; rb < M / 8; rb += F.G * NWAVES) {
        const int row0 = rb * 8, b = row0 / SEQ;
        f32x4 a[4], s[4], g2v[4];
#pragma unroll
        for (int j = 0; j < 4; ++j) {
            const int c = 4 * F.lane + 256 * j;
            if (NORM) { const f32x4 g = *(const f32x4*)(P_norm1_g + (size_t)l * D + c); const float* mp = P_mod + ((size_t)l * NB + b) * MODW;
                a[j] = g * (*(const f32x4*)(mp + D + c) + 1.0f); s[j] = *(const f32x4*)(mp + c); }
            if (COMBINE) g2v[j] = *(const f32x4*)(P_mod + ((size_t)(l - 1) * NB + b) * MODW + 5 * D + c);
        }
        for (int r = 0; r < 8; ++r) {
            const int row = row0 + r;
            f32x4 xv[4];
#pragma unroll
            for (int j = 0; j < 4; ++j) xv[j] = *(const f32x4*)(xin + (size_t)row * D + 4 * F.lane + 256 * j);
            if (COMBINE) {
                f32x4 y[4];
#pragma unroll
                for (int j = 0; j < 4; ++j) y[j] = (f32x4){0.f, 0.f, 0.f, 0.f};
#pragma unroll
                for (int k = 0; k < TOPK; ++k) {
                    const int so = P_slot[row * 4 + k]; const float gt = P_gate[row * 4 + k];
                    const int e = so >> 14, pos = so & 16383; const size_t orow = (size_t)X[32 + e] * 256 + pos;
#pragma unroll
                    for (int j = 0; j < 4; ++j) { const u32x2 w = *(const u32x2*)(P_OB + orow * D + 4 * F.lane + 256 * j);
                        y[j] += gt * (f32x4){bflo(w.x), bfhi(w.x), bflo(w.y), bfhi(w.y)}; }
                }
#pragma unroll
                for (int j = 0; j < 4; ++j) { xv[j] += g2v[j] * y[j]; *(f32x4*)(P_out + (size_t)row * D + 4 * F.lane + 256 * j) = xv[j]; }
            }
            if (NORM) {
                float ss = 0.f;
#pragma unroll
                for (int j = 0; j < 4; ++j) ss += (xv[j][0] * xv[j][0] + xv[j][1] * xv[j][1]) + (xv[j][2] * xv[j][2] + xv[j][3] * xv[j][3]);
                const float rstd = __builtin_amdgcn_rsqf(wave_sum(ss) * (1.f / D) + EPS);
#pragma unroll
                for (int j = 0; j < 4; ++j) { const f32x4 h = xv[j] * rstd * a[j] + s[j]; u32x2 w; w.x = pk2(h[0], h[1]); w.y = pk2(h[2], h[3]);
                    *(u32x2*)(P_XN + (size_t)row * D + 4 * F.lane + 256 * j) = w; }
            }
        }
    }
}

__device__ __forceinline__ void argmax_wave(float& v, int& e) {
#pragma unroll
    for (int o = 32; o >= 1; o >>= 1) { const float ov = __shfl_xor(v, o); const int oe = __shfl_xor(e, o); if (ov > v || (ov == v && oe < e)) { v = ov; e = oe; } }
}
__device__ __forceinline__ void phase_router(Frame& F, const Args& A, int l) {
    LAS f32x4* rw = (LAS f32x4*)F.lds;
    LAS int* X = (LAS int*)(F.lds + XTR_OFF);
    { const f32x4* src = (const f32x4*)(P_rwT + (size_t)l * NE * D); for (int i = F.tid; i < NE * D / 4; i += NWAVES * 64) rw[i] = src[i]; }
    if (F.tid < NE) X[F.tid] = 0;
    __syncthreads();
    for (int rb = F.vcu; rb < M / 64; rb += F.G) {
        const int row0 = rb * 64 + F.wave * 8, b = row0 / SEQ;
        f32x4 a[4], s[4];
#pragma unroll
        for (int j = 0; j < 4; ++j) { const int c = 4 * F.lane + 256 * j; const f32x4 g = *(const f32x4*)(P_norm2_g + (size_t)l * D + c); const float* mp = P_mod + ((size_t)l * NB + b) * MODW;
            a[j] = g * (*(const f32x4*)(mp + 4 * D + c) + 1.0f); s[j] = *(const f32x4*)(mp + 3 * D + c); }
        for (int pr = 0; pr < 4; ++pr) {
            f32x4 h[2][4];
#pragma unroll
            for (int r = 0; r < 2; ++r) {
                const int row = row0 + 2 * pr + r;
                float ss = 0.f;
#pragma unroll
                for (int j = 0; j < 4; ++j) { h[r][j] = *(const f32x4*)(P_out + (size_t)row * D + 4 * F.lane + 256 * j); ss += (h[r][j][0] * h[r][j][0] + h[r][j][1] * h[r][j][1]) + (h[r][j][2] * h[r][j][2] + h[r][j][3] * h[r][j][3]); }
                const float rstd = __builtin_amdgcn_rsqf(wave_sum(ss) * (1.f / D) + EPS);
#pragma unroll
                for (int j = 0; j < 4; ++j) { h[r][j] = h[r][j] * rstd * a[j] + s[j]; u32x2 w; w.x = pk2(h[r][j][0], h[r][j][1]); w.y = pk2(h[r][j][2], h[r][j][3]);
                    *(u32x2*)(P_XN + (size_t)row * D + 4 * F.lane + 256 * j) = w; }
            }
            float t16[2][16];
            { const bool up32 = (F.lane & 32) != 0;
#pragma unroll
              for (int i = 0; i < 16; ++i) {
                float pl0 = 0.f, pl1 = 0.f, ph0 = 0.f, ph1 = 0.f;
#pragma unroll
                for (int j = 0; j < 4; ++j) { const f32x4 wl = rw[i * 256 + 64 * j + F.lane], wh = rw[(i + 16) * 256 + 64 * j + F.lane];
                    pl0 += (h[0][j][0] * wl[0] + h[0][j][1] * wl[1]) + (h[0][j][2] * wl[2] + h[0][j][3] * wl[3]);
                    pl1 += (h[1][j][0] * wl[0] + h[1][j][1] * wl[1]) + (h[1][j][2] * wl[2] + h[1][j][3] * wl[3]);
                    ph0 += (h[0][j][0] * wh[0] + h[0][j][1] * wh[1]) + (h[0][j][2] * wh[2] + h[0][j][3] * wh[3]);
                    ph1 += (h[1][j][0] * wh[0] + h[1][j][1] * wh[1]) + (h[1][j][2] * wh[2] + h[1][j][3] * wh[3]); }
                t16[0][i] = (up32 ? ph0 : pl0) + __shfl_xor(up32 ? pl0 : ph0, 32);
                t16[1][i] = (up32 ? ph1 : pl1) + __shfl_xor(up32 ? pl1 : ph1, 32);
                asm volatile("" ::: "memory"); __builtin_amdgcn_sched_barrier(0);
              } }
#pragma unroll
            for (int r = 0; r < 2; ++r) {
                float t8[8], t4[4], t2[2];
                { const bool up = (F.lane & 16) != 0;
#pragma unroll
                  for (int i = 0; i < 8; ++i) { const float lo = t16[r][i], hi = t16[r][i + 8]; t8[i] = (up ? hi : lo) + __shfl_xor(up ? lo : hi, 16); } }
                { const bool up = (F.lane & 8) != 0;
#pragma unroll
                  for (int i = 0; i < 4; ++i) { const float lo = t8[i], hi = t8[i + 4]; t4[i] = (up ? hi : lo) + __shfl_xor(up ? lo : hi, 8); } }
                { const bool up = (F.lane & 4) != 0;
#pragma unroll
                  for (int i = 0; i < 2; ++i) { const float lo = t4[i], hi = t4[i + 2]; t2[i] = (up ? hi : lo) + __shfl_xor(up ? lo : hi, 4); } }
                float v;
                { const bool up = (F.lane & 2) != 0; const float lo = t2[0], hi = t2[1]; v = (up ? hi : lo) + __shfl_xor(up ? lo : hi, 2); }
                v += __shfl_xor(v, 1);
                const int me = F.lane >> 1;
                v += P_router_b[l * NE + me];
                float tv[4]; int te[4]; float cv = v;
#pragma unroll
                for (int k = 0; k < 4; ++k) { float bv = cv; int be = me; argmax_wave(bv, be); tv[k] = bv; te[k] = be; if (me == be) cv = -3.0e38f; }
                const float e1 = __expf(tv[1] - tv[0]), e2 = __expf(tv[2] - tv[0]), e3 = __expf(tv[3] - tv[0]); const float inv = 1.0f / (1.0f + e1 + e2 + e3);
                if (F.lane < 4) {
                    const int my_e = F.lane == 0 ? te[0] : F.lane == 1 ? te[1] : F.lane == 2 ? te[2] : te[3];
                    const float my_g = (F.lane == 0 ? 1.0f : F.lane == 1 ? e1 : F.lane == 2 ? e2 : e3) * inv;
                    const int lr = __hip_atomic_fetch_add(&X[my_e], 1, __ATOMIC_RELAXED, __HIP_MEMORY_SCOPE_WORKGROUP);
                    const int rl = F.wave * 8 + 2 * pr + r;
                    X[64 + rl * 4 + F.lane] = my_e | (lr << 8);
                    P_gate[(size_t)(rb * 64 + rl) * 4 + F.lane] = my_g;
                }
            }
        }
        __syncthreads();
        if (F.tid < NE) X[32 + F.tid] = (int)__hip_atomic_fetch_add(F.ctl + CW_CNT + 64 * l + F.tid, (unsigned)X[F.tid], RLX_AGENT);
        __syncthreads();
        if (F.tid < 256) { const int rl = F.tid >> 2, sv = X[64 + F.tid], e = sv & 255, lr = sv >> 8, pos = X[32 + e] + lr, row = rb * 64 + rl;
            P_tok[e * M + pos] = row; P_slot[row * 4 + (F.tid & 3)] = (e << 14) | pos; }
        __syncthreads();
        if (F.tid < NE) X[F.tid] = 0;
        __syncthreads();
    }
}

__device__ __forceinline__ void phase_attn_naive(Frame& F, const Args& A, int l) {
    LAS unsigned char* kt = F.lds + F.wave * 16384;
    LAS float* bt = (LAS float*)(F.lds + XTR_OFF) + F.wave * 320;
    const int h = F.wave;
    __syncthreads();
    for (int i = F.lane; i < 257; i += 64) bt[i] = P_rel_bias[((size_t)l * NH + h) * 257 + i] * LOG2E;
    LDS_WAIT();
    const int hf = F.lane >> 5, d0 = 32 * hf;
    for (int un = F.vcu; un < NB * NCH; un += F.G) {
        const int b = un / NCH, n = un % NCH;
#pragma unroll 1
        for (int pass = 0; pass < 2; ++pass) {
            const int qi = 32 * pass + (F.lane & 31); const int qrow = b * SEQ + n * CHUNK + qi;
            float q[32], o[32];
            { const u32x4* qp = (const u32x4*)(P_QKVU + (size_t)qrow * INW + h * HD + d0);
#pragma unroll
              for (int c = 0; c < 4; ++c) { const u32x4 w = qp[c]; q[8 * c + 0] = bflo(w.x); q[8 * c + 1] = bfhi(w.x); q[8 * c + 2] = bflo(w.y); q[8 * c + 3] = bfhi(w.y); q[8 * c + 4] = bflo(w.z); q[8 * c + 5] = bfhi(w.z); q[8 * c + 6] = bflo(w.w); q[8 * c + 7] = bfhi(w.w); } }
#pragma unroll
            for (int d = 0; d < 32; ++d) o[d] = 0.f;
            float mrun = -1.0e30f, lrun = 0.f;
#pragma unroll 1
            for (int jj = (n >= LEFTC ? 0 : LEFTC - n); jj <= LEFTC; ++jj) {
                const int krow = b * SEQ + (n - LEFTC + jj) * CHUNK + F.lane;
                { const u32x4* kp = (const u32x4*)(P_QKVU + (size_t)krow * INW + AW + h * HD); const u32x4* vp = (const u32x4*)(P_QKVU + (size_t)krow * INW + 2 * AW + h * HD);
#pragma unroll
                  for (int c = 0; c < 8; ++c) { *(LAS u32x4*)(kt + F.lane * 128 + 16 * c) = kp[c]; *(LAS u32x4*)(kt + 8192 + F.lane * 128 + 16 * c) = vp[c]; } }
                LDS_WAIT(); asm volatile("" ::: "memory");
#pragma unroll 1
                for (int key = 0; key < 64; ++key) {
                    float acc = 0.f;
#pragma unroll
                    for (int c = 0; c < 4; ++c) { const u32x4 w = *(const LAS u32x4*)(kt + key * 128 + 2 * d0 + 16 * c);
                        acc += q[8 * c + 0] * bflo(w.x) + q[8 * c + 1] * bfhi(w.x) + q[8 * c + 2] * bflo(w.y) + q[8 * c + 3] * bfhi(w.y) + q[8 * c + 4] * bflo(w.z) + q[8 * c + 5] * bfhi(w.z) + q[8 * c + 6] * bflo(w.w) + q[8 * c + 7] * bfhi(w.w); }
                    acc += __shfl_xor(acc, 32);
                    int rel = (jj - LEFTC) * CHUNK + key - qi; rel = rel < -128 ? -128 : (rel > 128 ? 128 : rel);
                    const float sc = acc + bt[rel + 128];
                    const float mnew = fmaxf(mrun, sc), alpha = __builtin_amdgcn_exp2f(mrun - mnew), p = __builtin_amdgcn_exp2f(sc - mnew);
                    mrun = mnew; lrun = lrun * alpha + p;
#pragma unroll
                    for (int c = 0; c < 4; ++c) { const u32x4 w = *(const LAS u32x4*)(kt + 8192 + key * 128 + 2 * d0 + 16 * c);
                        o[8 * c + 0] = o[8 * c + 0] * alpha + p * bflo(w.x); o[8 * c + 1] = o[8 * c + 1] * alpha + p * bfhi(w.x); o[8 * c + 2] = o[8 * c + 2] * alpha + p * bflo(w.y); o[8 * c + 3] = o[8 * c + 3] * alpha + p * bfhi(w.y);
                        o[8 * c + 4] = o[8 * c + 4] * alpha + p * bflo(w.z); o[8 * c + 5] = o[8 * c + 5] * alpha + p * bfhi(w.z); o[8 * c + 6] = o[8 * c + 6] * alpha + p * bflo(w.w); o[8 * c + 7] = o[8 * c + 7] * alpha + p * bfhi(w.w); }
                }
                LDS_WAIT(); asm volatile("" ::: "memory");
            }
            const float il = 1.0f / lrun;
            { u32x4* op = (u32x4*)(P_MIX + (size_t)qrow * D + h * HD + d0);
#pragma unroll
              for (int c = 0; c < 4; ++c) { u32x4 w; w.x = pk2(o[8 * c + 0] * il, o[8 * c + 1] * il); w.y = pk2(o[8 * c + 2] * il, o[8 * c + 3] * il); w.z = pk2(o[8 * c + 4] * il, o[8 * c + 5] * il); w.w = pk2(o[8 * c + 6] * il, o[8 * c + 7] * il); op[c] = w; } }
        }
    }
    __syncthreads();
}
__device__ __forceinline__ void phase_pool_naive(Frame& F, const Args& A, int l) {
    LAS float* dl = (LAS float*)F.lds;
    __syncthreads();
    for (int un = F.vcu; un < (M / 64) * 4; un += F.G) {
        const int rb = un >> 2, g = un & 3, w = 2 << g;
        { const int c = F.tid & 127, r0 = F.tid >> 7;
          for (int i = 0; i < 16; ++i) { const int r = r0 + 4 * i, row = rb * 64 + r, tpos = row % SEQ; const int cnt = (tpos + 1) < w ? (tpos + 1) : w;
              float sum = 0.f; for (int s = 0; s < cnt; ++s) sum += bflo((unsigned)P_QKVU[(size_t)(row - s) * INW + 3 * AW + g * PGRP + c]);
              const float ut = bflo((unsigned)P_QKVU[(size_t)row * INW + 3 * AW + g * PGRP + c]);
              dl[r * 129 + c] = sum / (float)cnt - ut; } }
        __syncthreads();
        { const int j = F.tid & 127, rq = F.tid >> 7; float acc[16];
#pragma unroll
          for (int i = 0; i < 16; ++i) acc[i] = 0.f;
          const float* pw = P_pool_w + ((size_t)(l * 4 + g) * PGRP) * PGRP + j;
          for (int c = 0; c < PGRP; ++c) { const float wv = pw[(size_t)c * PGRP];
#pragma unroll
              for (int i = 0; i < 16; ++i) acc[i] += dl[(rq + 4 * i) * 129 + c] * wv; }
          const float pb = P_pool_b[l * 512 + g * PGRP + j], ps = P_pool_scale[l * 512 + g * PGRP + j];
#pragma unroll
          for (int i = 0; i < 16; ++i) P_MIX[(size_t)(rb * 64 + rq + 4 * i) * D + AW + g * PGRP + j] = (bf16)f2bf((acc[i] + pb) * ps); }
        __syncthreads();
    }
}

constexpr int NSTEP = 1 + 7 * DEPTH + 1;

__global__ void __launch_bounds__(NWAVES * 64, 2) mk_fwd(Args args) {
    const Args& A = args;
    extern __shared__ __attribute__((aligned(16))) unsigned char lds[];
    Frame F;
    F.lds = (LAS unsigned char*)lds;
    F.MISC = (volatile LAS unsigned*)(F.lds + LDSCTL_OFF);
    F.tid = threadIdx.x; F.lane = F.tid & 63; F.wave = __builtin_amdgcn_readfirstlane(F.tid >> 6);
    F.G = gridDim.x; { const int bx = blockIdx.x; F.vcu = (F.G % 8 == 0) ? (bx % 8) * (F.G / 8) + bx / 8 : bx; }
    unsigned char* ws = args.ws;
    F.ctl = (gu32*)(ws + WS_CTL);
    for (int u = F.tid; u < 128; u += NWAVES * 64) ((LAS unsigned*)(F.lds + LDSCTL_OFF))[u] = 0u;
    __syncthreads();
    XcdBarrier bar; bar.bar = (unsigned*)(F.ctl + CW_BAR); bar.x = 0; bar.st = nullptr;
    const int lo = args.s_lo, hi = args.s_hi;
    if (hi - lo > 1) bar = xcd_barrier_post((unsigned*)(F.ctl + CW_BAR), F.MISC + 8);
#define IN(k) (lo <= (k) && (k) < hi)
#define OPAQUE() do { asm volatile("" : "+v"(F.tid)); F.lane = F.tid & 63; F.wave = __builtin_amdgcn_readfirstlane(F.tid >> 6); } while (0)
#define SEAM(k) do { if (IN(k) && IN((k) + 1)) xcd_barrier(bar); } while (0)

    if (IN(0)) { OPAQUE(); p0_mod(F, args); p0_convert(F, args); SEAM(0); }

    for (int l = 0; l < DEPTH; ++l) {
        const int sb = 1 + 7 * l;
        if (IN(sb + 0)) { OPAQUE(); if (l == 0) phase_cn<false, true>(F, args, l); else phase_cn<true, true>(F, args, l); SEAM(sb + 0); }
        if (IN(sb + 1)) { OPAQUE();
            pg8::DenseOrder S; S.init(M, INW, F.G, (int)blockIdx.x, P_XN, P_WIN + (size_t)l * INW * D);
            pg8::EpiWin E{P_QKVU, P_q_g + l * HD, P_k_g + l * HD};
            pg8::gemm_phase<pg8::EpiWin, pg8::DenseOrder, false>(F.lds + RING_OFF, S, E);
            SEAM(sb + 1);
        }
        if (IN(sb + 2)) { OPAQUE(); phase_attn_naive(F, args, l); OPAQUE(); phase_pool_naive(F, args, l); SEAM(sb + 2); }
        if (IN(sb + 3)) { OPAQUE();
            pg8::DenseOrder S; S.init(M, D, F.G, (int)blockIdx.x, P_MIX, P_WOUT + (size_t)l * D * D);
            pg8::EpiWout E{l == 0 ? P_x : P_out, P_out, P_mod + (size_t)l * NB * MODW + 2 * D};
            pg8::gemm_phase<pg8::EpiWout, pg8::DenseOrder, false>(F.lds + RING_OFF, S, E);
            SEAM(sb + 3);
        }
        if (IN(sb + 4)) { OPAQUE(); phase_router(F, args, l); SEAM(sb + 4); }
        if (IN(sb + 5)) { OPAQUE();
            const int T = moe_tables(F, l);
            LAS int* X = (LAS int*)(F.lds + XTR_OFF);
            pg8::MoeOrder S; S.tile_e = X + 128; S.toff = (const LAS unsigned*)(X + 512); S.T = T; S.vcu = F.vcu; S.G = F.G; S.ncol = 8; S.rpb = 4;
            S.A = (const char*)P_XN; S.B = (const char*)(P_W1 + (size_t)l * NE * 2048 * D); S.estride = (size_t)2048 * D * 2; S.gather = true;
            { pg8::GUnit u; for (int i = 0; i < MAXU && S.next(i, u); ++i) { if (F.tid < 256) { const int e = u.e, base = u.row0 - X[32 + e] * 256 + F.tid, cnt = X[e]; const int idx = base < cnt ? base : cnt - 1;
                    ((LAS unsigned*)(X + 512))[i * 256 + F.tid] = (unsigned)P_tok[e * M + idx] * (unsigned)(D * 2); } } }
            __syncthreads();
            pg8::EpiSwiglu E{P_H, P_exp_b1 + (size_t)l * NE * 2048};
            pg8::gemm_phase<pg8::EpiSwiglu, pg8::MoeOrder, true>(F.lds + RING_OFF, S, E);
            SEAM(sb + 5);
        }
        if (IN(sb + 6)) { OPAQUE();
            const int T = moe_tables(F, l);
            LAS int* X = (LAS int*)(F.lds + XTR_OFF);
            pg8::MoeOrder S; S.tile_e = X + 128; S.toff = (const LAS unsigned*)(X + 512); S.T = T; S.vcu = F.vcu; S.G = F.G; S.ncol = 4; S.rpb = 8;
            S.A = (const char*)P_H; S.B = (const char*)(P_W2 + (size_t)l * NE * D * FE); S.estride = (size_t)D * FE * 2; S.gather = false;
            pg8::EpiOB E{P_OB, P_exp_b2 + (size_t)l * NE * D};
            pg8::gemm_phase<pg8::EpiOB, pg8::MoeOrder, false>(F.lds + RING_OFF, S, E);
            SEAM(sb + 6);
        }
    }
    if (IN(NSTEP - 1)) { OPAQUE(); phase_cn<true, false>(F, args, DEPTH); }
#undef IN
#undef OPAQUE
#undef SEAM
}

extern "C" void kernel_launch(void* const* d_in, const int* in_sizes, int n_in, void* d_out, int out_size, void* d_ws, size_t ws_size, hipStream_t stream) {
    static int grid = 0;
    if (grid == 0) {
        if (n_in != 20 || in_sizes[0] != M * D || out_size != M * D || ws_size < WS_END) { fprintf(stderr, "kernel_launch: unexpected shapes / workspace (n_in %d, ws %zu)\n", n_in, ws_size); grid = -1; return; }
        int dev = 0, cus = 0, per_cu = 0;
        if (hipGetDevice(&dev) != hipSuccess || hipDeviceGetAttribute(&cus, hipDeviceAttributeMultiprocessorCount, dev) != hipSuccess) { grid = -1; return; }
        if (hipFuncSetAttribute((const void*)mk_fwd, hipFuncAttributeMaxDynamicSharedMemorySize, LDS_BYTES) != hipSuccess) { fprintf(stderr, "kernel_launch: hipFuncSetAttribute failed\n"); grid = -1; return; }
        if (hipOccupancyMaxActiveBlocksPerMultiprocessor(&per_cu, (const void*)mk_fwd, NWAVES * 64, LDS_BYTES) != hipSuccess || per_cu < 1) fprintf(stderr, "kernel_launch: occupancy query reports %d\n", per_cu);
        (void)hipGetLastError();
        grid = cus;
    }
    if (grid < 0) return;
    if (hipMemsetAsync((char*)d_ws + WS_CTL, 0, CTL_ZERO_BYTES, stream) != hipSuccess) return;
    Args a{};
    for (int i = 0; i < 20; ++i) a.in[i] = (const float*)d_in[i];
    a.out = (float*)d_out; a.ws = (unsigned char*)d_ws;
#if MK_ONE_LAUNCH
    a.s_lo = 0; a.s_hi = NSTEP;
    hipLaunchKernelGGL(mk_fwd, dim3(grid), dim3(NWAVES * 64), LDS_BYTES, stream, a);
#else
    for (int s = 0; s < NSTEP; ++s) { a.s_lo = s; a.s_hi = s + 1; hipLaunchKernelGGL(mk_fwd, dim3(grid), dim3(NWAVES * 64), LDS_BYTES, stream, a); }
#endif
}
```

```cpp
#include <hip/hip_runtime.h>
#include <cstdio>
#include <cstdint>

#ifndef MK_ONE_LAUNCH
#define MK_ONE_LAUNCH 1
#endif

#define GAS __attribute__((address_space(1)))
#define LAS __attribute__((address_space(3)))
typedef unsigned short bf16;
typedef unsigned u32x4 __attribute__((ext_vector_type(4)));
typedef unsigned u32x2 __attribute__((ext_vector_type(2)));
typedef float f32x4 __attribute__((ext_vector_type(4)));
typedef float f32x2 __attribute__((ext_vector_type(2)));
typedef short bf16x8 __attribute__((ext_vector_type(8)));
typedef GAS unsigned gu32;

constexpr int NB = 4, SEQ = 4096, D = 1024, M = NB * SEQ, DEPTH = 4;
constexpr int CHUNK = 64, NCH = SEQ / CHUNK, LEFTC = 8;
constexpr int NH = 8, HD = 64, AW = 512, PGRP = 128, INW = 2048;
constexpr int NE = 32, TOPK = 4, FE = 1024;
constexpr int MAXT = 288;
constexpr int MAXU = 9;
constexpr float EPS = 1e-6f;
constexpr float LOG2E = 1.4426950408889634f;
constexpr int MODW = 6 * D;

constexpr size_t MiB = 1u << 20;
constexpr size_t WS_CTL = 0, CTL_ZERO_BYTES = 1 * MiB;
constexpr size_t WS_MOD = 1 * MiB;
constexpr size_t WS_RWT = 2 * MiB;
constexpr size_t WS_GATE = 3 * MiB;
constexpr size_t WS_SLOT = 3 * MiB + 512 * 1024;
constexpr size_t WS_TOK = 4 * MiB;
constexpr size_t WS_WIN = 8 * MiB;
constexpr size_t WS_WOUT = 24 * MiB;
constexpr size_t WS_XN = 32 * MiB;
constexpr size_t WS_QKVU = 64 * MiB;
constexpr size_t WS_MIX = 128 * MiB;
constexpr size_t WS_H = 160 * MiB;
constexpr size_t WS_OB = 304 * MiB;
constexpr size_t WS_W1 = 448 * MiB;
constexpr size_t WS_W2 = 960 * MiB;
constexpr size_t WS_END = 1216 * MiB;
constexpr int CW_TMO = 0, CW_CODE = 1;
constexpr int CW_BAR = 4096;
constexpr int CW_CNT = 16384;

constexpr int RING_OFF = 0, RING_BYTES = 131072;
constexpr int LDSCTL_OFF = RING_BYTES;
constexpr int XTR_OFF = RING_BYTES + 512;
constexpr int LDS_BYTES = 147456;
constexpr int XTR_BYTES = LDS_BYTES - XTR_OFF;

#define RLX_AGENT __ATOMIC_RELAXED, __HIP_MEMORY_SCOPE_AGENT
#define LDS_WAIT() asm volatile("s_waitcnt lgkmcnt(0)" ::: "memory")
#define VM_WAIT() asm volatile("s_waitcnt vmcnt(0)" ::: "memory")
__device__ __forceinline__ unsigned f2bf(float f) { unsigned u = __builtin_bit_cast(unsigned, f); return (u + 0x7fffu + ((u >> 16) & 1u)) >> 16; }
__device__ __forceinline__ unsigned pk2(float lo, float hi) { return f2bf(lo) | (f2bf(hi) << 16); }
__device__ __forceinline__ unsigned cvt_pk_bf16(float lo, float hi) { unsigned r; asm volatile("v_cvt_pk_bf16_f32 %0, %1, %2" : "=v"(r) : "v"(lo), "v"(hi)); return r; }
__device__ __forceinline__ float bflo(unsigned u) { return __builtin_bit_cast(float, u << 16); }
__device__ __forceinline__ float bfhi(unsigned u) { return __builtin_bit_cast(float, u & 0xffff0000u); }
__device__ __forceinline__ float wave_sum(float v) {
#pragma unroll
    for (int o = 1; o < 64; o <<= 1) v += __shfl_xor(v, o);
    return v;
}

#define XB_TMO      128
#define XB_XCNT(j)  (256  + 64 * (j))
#define XB_XSUB(j)  (1280 + 64 * (j))
#define XB_XGEN(j)  (2304 + 64 * (j))
#define XB_TOP      3328
#define XB_TOPGEN   3392
#define XCD_BAR_WORDS 3456
#define XB_SPIN_CAP (1u << 18)
__device__ __forceinline__ unsigned xb_ld(unsigned* p)              { return __hip_atomic_load(p, __ATOMIC_RELAXED, __HIP_MEMORY_SCOPE_AGENT); }
__device__ __forceinline__ unsigned xb_add(unsigned* p, unsigned v) { return __hip_atomic_fetch_add(p, v, __ATOMIC_RELAXED, __HIP_MEMORY_SCOPE_AGENT); }
__device__ __forceinline__ unsigned xb_xcc_id() { return (unsigned)__builtin_amdgcn_s_getreg((3 << 11) | 20) & 0xFu; }
#define XB_SPIN(cond, bar) do { unsigned _sp = 0; while (cond) { __builtin_amdgcn_s_sleep(1); \
    if ((++_sp & 255u) == 0u) { if (xb_ld(&(bar)[XB_TMO])) break; if (_sp > XB_SPIN_CAP) { atomicAdd(&(bar)[XB_TMO], 1u); break; } } } } while (0)
struct XcdBarrier { unsigned* bar; unsigned x; volatile LAS unsigned* st; };
__device__ __forceinline__ XcdBarrier xcd_barrier_post(unsigned* bar, volatile LAS unsigned* st) {
    XcdBarrier b; b.bar = bar; b.x = xb_xcc_id(); b.st = st;
    if (threadIdx.x == 0) (void)xb_add(&bar[XB_XCNT(b.x)], 1u);
    return b;
}
__device__ __forceinline__ void xcd_barrier_complete(unsigned* bar, unsigned x, unsigned& nloc, unsigned& nx) {
    const unsigned G = gridDim.x * gridDim.y * gridDim.z;
    unsigned sum, cnt, mine, sp = 0u;
    for (;;) {
        sum = 0u; cnt = 0u; mine = 0u;
#pragma unroll
        for (unsigned j = 0; j < 16; ++j) { const unsigned c = xb_ld(&bar[XB_XCNT(j)]); sum += c; cnt += (c > 0u) ? 1u : 0u; mine = (j == x) ? c : mine; }
        if (sum == G) break;
        __builtin_amdgcn_s_sleep(1);
        if ((++sp & 255u) == 0u) { if (xb_ld(&bar[XB_TMO])) break; if (sp > XB_SPIN_CAP) { atomicAdd(&bar[XB_TMO], 1u); break; } }
    }
    nloc = mine > 0u ? mine : 1u; nx = cnt > 0u ? cnt : 1u;
}
__device__ __forceinline__ void xcd_barrier(const XcdBarrier& b) {
    asm volatile("s_waitcnt vmcnt(0)" ::: "memory");
    __syncthreads();
    if (threadIdx.x == 0) {
        unsigned* bar = b.bar;
        __builtin_amdgcn_s_waitcnt(0);
        unsigned nloc = b.st[0], nx = b.st[1];
        if (nloc == 0u) { xcd_barrier_complete(bar, b.x, nloc, nx); b.st[0] = nloc; b.st[1] = nx; }
        const unsigned old = xb_add(&bar[XB_XSUB(b.x)], 1u);
        const unsigned gen = old / nloc;
        if (old + 1u == (gen + 1u) * nloc) {
            __builtin_amdgcn_fence(__ATOMIC_RELEASE, "agent");
            asm volatile("s_waitcnt vmcnt(0)" ::: "memory");
            const unsigned og = xb_add(&bar[XB_TOP], 1u);
            const unsigned tg = og / nx;
            if (og + 1u == (tg + 1u) * nx) xb_add(&bar[XB_TOPGEN], 1u);
            else XB_SPIN(xb_ld(&bar[XB_TOPGEN]) == tg, bar);
            __builtin_amdgcn_fence(__ATOMIC_ACQUIRE, "agent");
            xb_add(&bar[XB_XGEN(b.x)], 1u);
            asm volatile("s_waitcnt vmcnt(0)" ::: "memory");
        } else {
            XB_SPIN(xb_ld(&bar[XB_XGEN(b.x)]) == gen, bar);
            __builtin_amdgcn_fence(__ATOMIC_ACQUIRE, "agent");
            asm volatile("s_waitcnt vmcnt(0)" ::: "memory");
        }
    }
    __syncthreads();
}

namespace pg8 {
constexpr int BM = 256, BK = 64, HALF = 128, HTB = HALF * BK * 2, STAGE_BYTES = 8 * HTB, NXCD = 8, WGM = 8, KD = 1024;
constexpr size_t KSTEP = (size_t)BK * 2, HSTEP = (size_t)HALF * KD * 2, TSTEP = 2 * HSTEP;
__host__ __device__ __forceinline__ int lds_byte(int r, int c) { const int st = (r >> 4) * 2 + (c >> 5), rr = r & 15, cc = c & 31, ob = rr * 64 + cc * 2; return st * 1024 + (ob ^ (((ob >> 9) & 1) << 5)); }
__host__ __device__ __forceinline__ void stage_rc(int b, int& R, int& C) { const int st = b / 1024, sb = b % 1024, swz = sb ^ (((sb >> 9) & 1) << 5); R = (st >> 1) * 16 + swz / 64; C = (st & 1) * 32 + (swz % 64) / 2; }
__host__ __device__ __forceinline__ int perm32(int rho) { const int n = rho >> 4, i = rho & 15; return 8 * (i >> 2) + 4 * n + (i & 3); }

struct GUnit { const char* A; const char* B; int row0; int pn; int e; int li; };

struct DenseOrder {
    int nM, nN, nwg, G, c; const char* A; const char* B;
    __device__ __forceinline__ void init(int M_, int N_, int G_, int c_, const void* A_, const void* B_) { nM = M_ / BM; nN = N_ / BM; nwg = nM * nN; G = G_; c = c_; A = (const char*)A_; B = (const char*)B_; }
    __device__ __forceinline__ bool next(int i, GUnit& u) const {
        const long L = (long)i * G + c; if (L >= nwg) return false;
        int wgid = (int)L; { const int q = nwg / NXCD, r = nwg % NXCD, xcd = wgid % NXCD, off = wgid / NXCD; wgid = (xcd < r ? xcd * (q + 1) : r * (q + 1) + (xcd - r) * q) + off; }
        const int nig = WGM * nN, gid = wgid / nig, fm = gid * WGM, gsz = (nM - fm) < WGM ? (nM - fm) : WGM;
        const int pm = fm + ((wgid % nig) % gsz), pn = (wgid % nig) / gsz;
        u.A = A + (size_t)pm * TSTEP; u.B = B + (size_t)pn * TSTEP; u.row0 = pm * BM; u.pn = pn; u.e = 0; u.li = i; return true;
    }
    __device__ __forceinline__ unsigned tokoff(int, int) const { return 0u; }
};
struct MoeOrder {
    const LAS int* tile_e; const LAS unsigned* toff;
    int T, vcu, G, ncol, rpb; const char* A; const char* B; size_t estride; bool gather;
    __device__ __forceinline__ bool next(int i, GUnit& u) const {
        const int uu = vcu + i * G; if (uu >= T * ncol) return false;
        const int blk = uu >> 5, j = uu & 31; int tib = T - blk * rpb; tib = tib > rpb ? rpb : tib;
        const int tile = blk * rpb + j % tib, pn = j / tib;
        const int e = __builtin_amdgcn_readfirstlane(tile_e[tile]);
        u.row0 = tile * BM; u.pn = pn; u.e = e; u.li = i;
        u.A = gather ? A : A + (size_t)tile * TSTEP; u.B = B + (size_t)e * estride + (size_t)pn * TSTEP; return true;
    }
    __device__ __forceinline__ unsigned tokoff(int li, int r) const { return toff[li * 256 + r]; }
};

typedef f32x4 Acc[2][2][4][2];

struct EpiWin {
    static constexpr bool PERM = true;
    bf16* O; const float* qg; const float* kg;
    __device__ __forceinline__ void operator()(const Acc& acc, const GUnit& u, int wr, int wc, int fr, int fq) const {
        const int kind = u.pn >> 1;
        const int col0 = u.pn * 256 + 64 * wc + 8 * fq;
        f32x4 gv[2][2];
#pragma unroll
        for (int bj = 0; bj < 2; ++bj)
#pragma unroll
            for (int n = 0; n < 2; ++n) {
                const int d = 32 * bj + 8 * fq + 4 * n;
                if (kind == 0) gv[bj][n] = *(const f32x4*)(qg + d) * (0.125f * LOG2E);
                else if (kind == 1) gv[bj][n] = *(const f32x4*)(kg + d);
                else gv[bj][n] = (f32x4){1.f, 1.f, 1.f, 1.f};
            }
#pragma unroll
        for (int ai = 0; ai < 2; ++ai)
#pragma unroll
            for (int m = 0; m < 4; ++m) {
                const int row = u.row0 + ai * HALF + wr * 64 + m * 16 + fr;
                float rstd = 1.f;
                if (kind < 2) {
                    float ss = 0.f;
#pragma unroll
                    for (int bj = 0; bj < 2; ++bj)
#pragma unroll
                        for (int n = 0; n < 2; ++n) { const f32x4 x = acc[ai][bj][m][n]; ss += (x[0] * x[0] + x[1] * x[1]) + (x[2] * x[2] + x[3] * x[3]); }
                    ss += __shfl_xor(ss, 16); ss += __shfl_xor(ss, 32);
                    rstd = __builtin_amdgcn_rsqf(ss * (1.f / 64.f) + EPS);
                }
                bf16* rowp = O + (size_t)row * INW + col0;
#pragma unroll
                for (int bj = 0; bj < 2; ++bj) {
                    const f32x4 v0 = acc[ai][bj][m][0] * rstd * gv[bj][0], v1 = acc[ai][bj][m][1] * rstd * gv[bj][1];
                    u32x4 w; w.x = cvt_pk_bf16(v0[0], v0[1]); w.y = cvt_pk_bf16(v0[2], v0[3]); w.z = cvt_pk_bf16(v1[0], v1[1]); w.w = cvt_pk_bf16(v1[2], v1[3]);
                    *(u32x4*)(rowp + 32 * bj) = w;
                }
            }
    }
};
struct EpiWout {
    static constexpr bool PERM = false;
    const float* xin; float* xout; const float* g1;
    __device__ __forceinline__ void operator()(const Acc& acc, const GUnit& u, int wr, int wc, int fr, int fq) const {
        const int b = u.row0 / SEQ; const int col0 = u.pn * BM + wc * 32 + 4 * fq;
        f32x4 gv[2][2];
#pragma unroll
        for (int bj = 0; bj < 2; ++bj)
#pragma unroll
            for (int n = 0; n < 2; ++n) gv[bj][n] = *(const f32x4*)(g1 + (size_t)b * MODW + col0 + bj * HALF + n * 16);
#pragma unroll
        for (int ai = 0; ai < 2; ++ai)
#pragma unroll
            for (int m = 0; m < 4; ++m) {
                const size_t off = (size_t)(u.row0 + ai * HALF + wr * 64 + m * 16 + fr) * D + col0;
#pragma unroll
                for (int bj = 0; bj < 2; ++bj)
#pragma unroll
                    for (int n = 0; n < 2; ++n) { const f32x4 xv = *(const f32x4*)(xin + off + bj * HALF + n * 16); *(f32x4*)(xout + off + bj * HALF + n * 16) = xv + gv[bj][n] * acc[ai][bj][m][n]; }
                if (m & 1) asm volatile("" ::: "memory");
            }
    }
};
struct EpiSwiglu {
    static constexpr bool PERM = true;
    bf16* H; const float* b1;
    __device__ __forceinline__ void operator()(const Acc& acc, const GUnit& u, int wr, int wc, int fr, int fq) const {
        const int j0 = u.pn * 128 + wc * 32 + 8 * fq; const float* be = b1 + (size_t)u.e * 2048 + j0;
        f32x4 bg[2], bl[2];
#pragma unroll
        for (int n = 0; n < 2; ++n) { bg[n] = *(const f32x4*)(be + 4 * n); bl[n] = *(const f32x4*)(be + 1024 + 4 * n); }
#pragma unroll
        for (int ai = 0; ai < 2; ++ai)
#pragma unroll
            for (int m = 0; m < 4; ++m) {
                bf16* rowp = H + (size_t)(u.row0 + ai * HALF + wr * 64 + m * 16 + fr) * FE + j0;
                float o[8];
#pragma unroll
                for (int n = 0; n < 2; ++n)
#pragma unroll
                    for (int i = 0; i < 4; ++i) {
                        float g = acc[ai][0][m][n][i] + bg[n][i], l = acc[ai][1][m][n][i] + bl[n][i];
                        g = fminf(g, 7.0f); l = fminf(fmaxf(l, -7.0f), 7.0f);
                        const float sg = __builtin_amdgcn_rcpf(1.0f + __builtin_amdgcn_exp2f(-1.702f * LOG2E * g));
                        o[4 * n + i] = g * sg * (l + 1.0f);
                    }
                u32x4 w; w.x = cvt_pk_bf16(o[0], o[1]); w.y = cvt_pk_bf16(o[2], o[3]); w.z = cvt_pk_bf16(o[4], o[5]); w.w = cvt_pk_bf16(o[6], o[7]);
                *(u32x4*)rowp = w;
            }
    }
};
struct EpiOB {
    static constexpr bool PERM = true;
    bf16* O; const float* b2;
    __device__ __forceinline__ void operator()(const Acc& acc, const GUnit& u, int wr, int wc, int fr, int fq) const {
        const int col0 = u.pn * BM + wc * 32 + 8 * fq; const float* be = b2 + (size_t)u.e * D + col0;
        f32x4 bv[2][2];
#pragma unroll
        for (int bj = 0; bj < 2; ++bj)
#pragma unroll
            for (int n = 0; n < 2; ++n) bv[bj][n] = *(const f32x4*)(be + bj * HALF + 4 * n);
#pragma unroll
        for (int ai = 0; ai < 2; ++ai)
#pragma unroll
            for (int m = 0; m < 4; ++m) {
                bf16* rowp = O + (size_t)(u.row0 + ai * HALF + wr * 64 + m * 16 + fr) * D + col0;
#pragma unroll
                for (int bj = 0; bj < 2; ++bj) {
                    const f32x4 v0 = acc[ai][bj][m][0] + bv[bj][0], v1 = acc[ai][bj][m][1] + bv[bj][1];
                    u32x4 w; w.x = cvt_pk_bf16(v0[0], v0[1]); w.y = cvt_pk_bf16(v0[2], v0[3]); w.z = cvt_pk_bf16(v1[0], v1[1]); w.w = cvt_pk_bf16(v1[2], v1[3]);
                    *(u32x4*)(rowp + bj * HALF) = w;
                }
            }
    }
};

template <class Epi, class Sched, bool GATHER>
__device__ __forceinline__ void gemm_phase(LAS unsigned char* lds, const Sched& S, const Epi& E) {
    int tid_ = threadIdx.x; asm volatile("" : "+v"(tid_));
    const int tid = tid_, wid = __builtin_amdgcn_readfirstlane(tid >> 6), lane = tid & 63, wr = wid >> 2, wc = wid & 3, fr = lane & 15, fq = lane >> 4;
    constexpr int K = KD, nt = K / BK;
    unsigned voffA[2], voffB[2]; int RA[2]; unsigned CA[2];
#pragma unroll
    for (int i = 0; i < 2; ++i) { int R, C; stage_rc(tid * 16 + i * 8192, R, C); const int Rb = Epi::PERM ? ((R & ~31) + perm32(R & 31)) : R;
        voffA[i] = (unsigned)(R * K + C) * 2u; voffB[i] = (unsigned)(Rb * K + C) * 2u; RA[i] = R; CA[i] = (unsigned)C * 2u; }
    constexpr size_t kstep = KSTEP, hstep = HSTEP;
    const unsigned ldsw = (unsigned)wid * 1024u;
    const int aoff = lds_byte(wr * 64 + fr, fq * 8), boff = lds_byte(wc * 32 + fr, fq * 8);
#define PG8_SA(b, h) (((b) * 2 + (h)) * HTB)
#define PG8_SB(b, h) ((4 + (b) * 2 + (h)) * HTB)
#define PG8_STAGE(bufoff, gbase, voff) do { _Pragma("unroll") for (int _i = 0; _i < 2; ++_i) \
        __builtin_amdgcn_global_load_lds((const unsigned*)((const char*)(gbase) + (voff)[_i]), (LAS unsigned*)(lds + (bufoff) + ldsw + _i * 8192), 16, 0, 0); } while (0)
#define PG8_STAGE_A(bufoff, base, h, V) do { if constexpr (GATHER) { PG8_STAGE(bufoff, base, (V)[h]); } else { PG8_STAGE(bufoff, (base) + (h) * hstep, voffA); } } while (0)
#define PG8_LDA(dst, b, h) do { _Pragma("unroll") for (int m = 0; m < 4; ++m) _Pragma("unroll") for (int k = 0; k < 2; ++k) dst[m][k] = *(const LAS bf16x8*)(lds + PG8_SA(b, h) + aoff + m * 2048 + k * 1024); } while (0)
#define PG8_LDB(dst, b, h) do { _Pragma("unroll") for (int n = 0; n < 2; ++n) _Pragma("unroll") for (int k = 0; k < 2; ++k) dst[n][k] = *(const LAS bf16x8*)(lds + PG8_SB(b, h) + boff + n * 2048 + k * 1024); } while (0)
#define PG8_MMA(ai, bj, At, Bt) do { __builtin_amdgcn_s_setprio(1); _Pragma("unroll") for (int m = 0; m < 4; ++m) _Pragma("unroll") for (int n = 0; n < 2; ++n) _Pragma("unroll") for (int k = 0; k < 2; ++k) \
        acc[ai][bj][m][n] = __builtin_amdgcn_mfma_f32_16x16x32_bf16(Bt[n][k], At[m][k], acc[ai][bj][m][n], 0, 0, 0); __builtin_amdgcn_s_setprio(0); } while (0)
#define PG8_WAIT_V(n) asm volatile("s_waitcnt vmcnt(" #n ")" ::: "memory")
#define PG8_WAIT_L(n) asm volatile("s_waitcnt lgkmcnt(" #n ")" ::: "memory")
#define PG8_BAR __builtin_amdgcn_s_barrier()
#define PG8_SCHED __builtin_amdgcn_sched_barrier(0)
#define PG8_AOFF(V, U) do { if constexpr (GATHER) { _Pragma("unroll") for (int _h = 0; _h < 2; ++_h) _Pragma("unroll") for (int _i = 0; _i < 2; ++_i) (V)[_h][_i] = S.tokoff((U).li, _h * HALF + RA[_i]) + CA[_i]; } } while (0)
    GUnit cur, nxt; int ui = 0;
    if (!S.next(0, cur)) return;
    Acc acc;
#pragma unroll
    for (int a = 0; a < 2; ++a)
#pragma unroll
        for (int b = 0; b < 2; ++b)
#pragma unroll
            for (int m = 0; m < 4; ++m)
#pragma unroll
                for (int n = 0; n < 2; ++n) acc[a][b][m][n] = (f32x4){0.f, 0.f, 0.f, 0.f};
    bf16x8 At[4][2], B0[2][2], B1[2][2];
    unsigned va[2][2] = {{0u, 0u}, {0u, 0u}};
    const char* cA = cur.A; const char* cB = cur.B;
    PG8_AOFF(va, cur);
    PG8_STAGE(PG8_SB(0, 0), cB, voffB); PG8_STAGE(PG8_SB(0, 1), cB + hstep, voffB); PG8_STAGE_A(PG8_SA(0, 0), cA, 0, va); PG8_STAGE_A(PG8_SA(0, 1), cA, 1, va);
    if (wr == 1) PG8_BAR;
    PG8_WAIT_V(2); PG8_BAR;
    PG8_STAGE(PG8_SB(1, 0), cB + kstep, voffB); PG8_STAGE_A(PG8_SA(1, 0), cA + kstep, 0, va); PG8_STAGE(PG8_SB(1, 1), cB + hstep + kstep, voffB);
    PG8_WAIT_V(6); PG8_BAR;
    for (;;) {
        const bool has_next = S.next(ui + 1, nxt);
        const char* nA = has_next ? nxt.A : cA; const char* nB = has_next ? nxt.B : cB;
        for (int t = 0; t < nt; t += 2) {
            const bool last = (t == nt - 2);
            const char* a1 = cA + (size_t)(t + 1) * kstep;
            const char* a2 = last ? nA : cA + (size_t)(t + 2) * kstep; const char* b2 = last ? nB : cB + (size_t)(t + 2) * kstep;
            const char* a3 = a2 + kstep; const char* b3 = b2 + kstep;
            PG8_LDB(B0, 0, 0); PG8_LDB(B1, 0, 1); PG8_SCHED; PG8_LDA(At, 0, 0); PG8_STAGE_A(PG8_SA(1, 1), a1, 1, va);
            if constexpr (GATHER) { if (last && has_next) { PG8_AOFF(va, nxt); } }
            PG8_WAIT_V(8); PG8_WAIT_L(0); PG8_BAR; PG8_MMA(0, 0, At, B0); PG8_MMA(0, 1, At, B1); PG8_BAR; PG8_SCHED;
            PG8_LDA(At, 0, 1); PG8_STAGE(PG8_SB(0, 0), b2, voffB); PG8_STAGE(PG8_SB(0, 1), b2 + hstep, voffB); PG8_STAGE_A(PG8_SA(0, 0), a2, 0, va);
            PG8_WAIT_V(8); PG8_WAIT_L(0); PG8_BAR; PG8_MMA(1, 0, At, B0); PG8_MMA(1, 1, At, B1); PG8_BAR; PG8_SCHED;
            PG8_LDB(B0, 1, 0); PG8_LDB(B1, 1, 1); PG8_SCHED; PG8_LDA(At, 1, 0); PG8_STAGE_A(PG8_SA(0, 1), a2, 1, va);
            PG8_WAIT_V(8); PG8_WAIT_L(0); PG8_BAR; PG8_MMA(0, 0, At, B0); PG8_MMA(0, 1, At, B1); PG8_BAR; PG8_SCHED;
            PG8_LDA(At, 1, 1); PG8_STAGE(PG8_SB(1, 0), b3, voffB); PG8_STAGE(PG8_SB(1, 1), b3 + hstep, voffB); PG8_STAGE_A(PG8_SA(1, 0), a3, 0, va);
            PG8_WAIT_V(8); PG8_WAIT_L(0); PG8_BAR; PG8_MMA(1, 0, At, B0); PG8_MMA(1, 1, At, B1); PG8_BAR; PG8_SCHED;
        }
        if (wr == 0) PG8_BAR;
        E(acc, cur, wr, wc, fr, fq);
        if (!has_next) break;
#pragma unroll
        for (int a = 0; a < 2; ++a)
#pragma unroll
            for (int b = 0; b < 2; ++b)
#pragma unroll
                for (int m = 0; m < 4; ++m)
#pragma unroll
                    for (int n = 0; n < 2; ++n) acc[a][b][m][n] = (f32x4){0.f, 0.f, 0.f, 0.f};
        cur = nxt; cA = nA; cB = nB; ++ui;
        if (wr == 1) PG8_BAR;
    }
    PG8_WAIT_V(0);
    PG8_BAR;
#undef PG8_SA
#undef PG8_SB
#undef PG8_STAGE
#undef PG8_STAGE_A
#undef PG8_LDA
#undef PG8_LDB
#undef PG8_MMA
#undef PG8_WAIT_V
#undef PG8_WAIT_L
#undef PG8_BAR
#undef PG8_SCHED
#undef PG8_AOFF
}
}

struct Args { const float* in[20]; float* out; unsigned char* ws; int s_lo, s_hi; };
#define P_x (A.in[0])
#define P_c (A.in[1])
#define P_norm1_g (A.in[2])
#define P_w_mod (A.in[3])
#define P_b_mod (A.in[4])
#define P_w_in (A.in[5])
#define P_q_g (A.in[6])
#define P_k_g (A.in[7])
#define P_rel_bias (A.in[8])
#define P_pool_w (A.in[9])
#define P_pool_b (A.in[10])
#define P_pool_scale (A.in[11])
#define P_w_out (A.in[12])
#define P_norm2_g (A.in[13])
#define P_router_w (A.in[14])
#define P_router_b (A.in[15])
#define P_exp_w1 (A.in[16])
#define P_exp_b1 (A.in[17])
#define P_exp_w2 (A.in[18])
#define P_exp_b2 (A.in[19])
#define P_out (A.out)
#define P_mod ((float*)(A.ws + WS_MOD))
#define P_rwT ((float*)(A.ws + WS_RWT))
#define P_gate ((float*)(A.ws + WS_GATE))
#define P_slot ((int*)(A.ws + WS_SLOT))
#define P_tok ((int*)(A.ws + WS_TOK))
#define P_WIN ((bf16*)(A.ws + WS_WIN))
#define P_WOUT ((bf16*)(A.ws + WS_WOUT))
#define P_XN ((bf16*)(A.ws + WS_XN))
#define P_QKVU ((bf16*)(A.ws + WS_QKVU))
#define P_MIX ((bf16*)(A.ws + WS_MIX))
#define P_H ((bf16*)(A.ws + WS_H))
#define P_OB ((bf16*)(A.ws + WS_OB))
#define P_W1 ((bf16*)(A.ws + WS_W1))
#define P_W2 ((bf16*)(A.ws + WS_W2))
constexpr int NWAVES = 8;
struct Frame {
    LAS unsigned char* lds;
    volatile LAS unsigned* MISC;
    gu32* ctl;
    int tid, lane, wave, vcu, G;
};

__device__ __forceinline__ void p0_mod(Frame& F, const Args& A) {
    LAS float* cond = (LAS float*)(F.lds);
    LAS float* red = (LAS float*)(F.lds + 16384);
    for (int i = F.tid; i < NB * D; i += NWAVES * 64) { const float cv = P_c[i]; cond[i] = cv / (1.f + __expf(-cv)); }
    __syncthreads();
    const int c4 = F.lane & 31, rs = F.lane >> 5;
    for (int it = F.vcu; it < DEPTH * (MODW / 128); it += F.G) {
        const int l = it / (MODW / 128), cb = it % (MODW / 128);
        f32x4 acc[4];
#pragma unroll
        for (int b = 0; b < 4; ++b) acc[b] = (f32x4){0.f, 0.f, 0.f, 0.f};
        const float* wp = P_w_mod + ((size_t)l * D + 128 * F.wave + rs) * MODW + 128 * cb + 4 * c4;
#pragma unroll 8
        for (int kk = 0; kk < 64; ++kk) {
            const f32x4 wv = *(const f32x4*)(wp + (size_t)(2 * kk) * MODW);
            const int k = 128 * F.wave + 2 * kk + rs;
#pragma unroll
            for (int b = 0; b < 4; ++b) acc[b] += cond[b * D + k] * wv;
        }
#pragma unroll
        for (int b = 0; b < 4; ++b)
#pragma unroll
            for (int i = 0; i < 4; ++i) acc[b][i] += __shfl_xor(acc[b][i], 32);
        if (rs == 0) {
#pragma unroll
            for (int b = 0; b < 4; ++b) *(LAS f32x4*)(red + (F.wave * 4 + b) * 128 + 4 * c4) = acc[b];
        }
        __syncthreads();
        { const int b = F.tid >> 7, col = F.tid & 127; float s = 0.f;
#pragma unroll
          for (int w = 0; w < 8; ++w) s += red[(w * 4 + b) * 128 + col];
          P_mod[((size_t)l * NB + b) * MODW + 128 * cb + col] = s + P_b_mod[(size_t)l * MODW + 128 * cb + col]; }
        __syncthreads();
    }
    __syncthreads();
}
__device__ __forceinline__ void tr_item(const float* W, int N, bf16* WT, int k0, int n0, int drow, LAS float* scr, int lane) {
#pragma unroll 8
    for (int i = 0; i < 32; ++i) { const int kk = 2 * i + (lane >> 5); scr[kk * 33 + (lane & 31)] = W[(size_t)(k0 + kk) * N + n0 + (lane & 31)]; }
    LDS_WAIT(); asm volatile("" ::: "memory");
    const int c = lane & 7;
#pragma unroll
    for (int j = 0; j < 4; ++j) { const int n = (lane >> 3) + 8 * j; const LAS float* s = scr + (8 * c) * 33 + n;
        u32x4 o; o.x = pk2(s[0 * 33], s[1 * 33]); o.y = pk2(s[2 * 33], s[3 * 33]); o.z = pk2(s[4 * 33], s[5 * 33]); o.w = pk2(s[6 * 33], s[7 * 33]);
        *(GAS u32x4*)(WT + (size_t)(drow + n) * 1024 + k0 + 8 * c) = o; }
    LDS_WAIT(); asm volatile("" ::: "memory");
}
__device__ __forceinline__ void p0_convert(Frame& F, const Args& A) {
    LAS float* scr = (LAS float*)(F.lds + RING_OFF + F.wave * 16384);
    const int gw = F.vcu * NWAVES + F.wave, NGW = F.G * NWAVES;
    constexpr int I_IN = DEPTH * 16 * 64, I_OUT = DEPTH * 16 * 32, I_W1 = DEPTH * NE * 16 * 64, I_W2 = DEPTH * NE * 16 * 32;
    for (int it = gw; it < I_IN + I_OUT + I_W1 + I_W2; it += NGW) {
        int r = it;
        if (r < I_IN) { const int l = r >> 10, rr = r & 1023, kb = rr >> 6, nb = rr & 63, n0 = 32 * nb, g = (n0 & 255) >> 5;
            tr_item(P_w_in + (size_t)l * D * INW, INW, P_WIN + (size_t)l * INW * D, 64 * kb, n0, (n0 & ~255) + 128 * (g & 1) + 32 * (g >> 1), scr, F.lane); continue; }
        r -= I_IN;
        if (r < I_OUT) { const int l = r >> 9, rr = r & 511, kb = rr >> 5, nb = rr & 31;
            tr_item(P_w_out + (size_t)l * D * D, D, P_WOUT + (size_t)l * D * D, 64 * kb, 32 * nb, 32 * nb, scr, F.lane); continue; }
        r -= I_OUT;
        if (r < I_W1) { const int le = r >> 10, rr = r & 1023, kb = rr >> 6, nb = rr & 63, n0 = 32 * nb, bj = n0 >> 10, jj = n0 & 1023;
            tr_item(P_exp_w1 + (size_t)le * D * 2048, 2048, P_W1 + (size_t)le * 2048 * D, 64 * kb, n0, 256 * (jj >> 7) + 128 * bj + (jj & 127), scr, F.lane); continue; }
        r -= I_W1;
        { const int le = r >> 9, rr = r & 511, kb = rr >> 5, nb = rr & 31;
            tr_item(P_exp_w2 + (size_t)le * FE * D, D, P_W2 + (size_t)le * D * FE, 64 * kb, 32 * nb, 32 * nb, scr, F.lane); }
    }
    for (int i = (F.vcu * NWAVES * 64 + F.tid); i < DEPTH * NE * D; i += F.G * NWAVES * 64) { const int l = i >> 15, e = (i >> 10) & 31, cc = i & 1023; P_rwT[i] = P_router_w[((size_t)l * D + cc) * NE + e]; }
}

__device__ __forceinline__ int moe_tables(Frame& F, int l) {
    LAS int* X = (LAS int*)(F.lds + XTR_OFF);
    __syncthreads();
    if (F.tid < NE) X[F.tid] = (int)__hip_atomic_load(F.ctl + CW_CNT + 64 * l + F.tid, RLX_AGENT);
    __syncthreads();
    if (F.tid == 0) { int t = 0; for (int e = 0; e < NE; ++e) { X[32 + e] = t; t += (X[e] + 255) >> 8; } X[32 + NE] = t; X[66] = t; }
    __syncthreads();
    if (F.tid < NE) { const int t0 = X[32 + F.tid], t1 = X[33 + F.tid]; for (int t = t0; t < t1; ++t) X[128 + t] = F.tid; }
    __syncthreads();
    return X[66];
}

template <bool COMBINE, bool NORM>
__device__ __forceinline__ void phase_cn(Frame& F, const Args& A, int l) {
    LAS int* X = (LAS int*)(F.lds + XTR_OFF);
    if (COMBINE) (void)moe_tables(F, l - 1);
    const float* xin = (COMBINE || l > 0) ? P_out : P_x;
    for (int rb = F.vcu * NWAVES + F.wave; rb < M / 8; rb += F.G * NWAVES) {
        const int row0 = rb * 8, b = row0 / SEQ;
        f32x4 a[4], s[4], g2v[4];
#pragma unroll
        for (int j = 0; j < 4; ++j) {
            const int c = 4 * F.lane + 256 * j;
            if (NORM) { const f32x4 g = *(const f32x4*)(P_norm1_g + (size_t)l * D + c); const float* mp = P_mod + ((size_t)l * NB + b) * MODW;
                a[j] = g * (*(const f32x4*)(mp + D + c) + 1.0f); s[j] = *(const f32x4*)(mp + c); }
            if (COMBINE) g2v[j] = *(const f32x4*)(P_mod + ((size_t)(l - 1) * NB + b) * MODW + 5 * D + c);
        }
        for (int r = 0; r < 8; ++r) {
            const int row = row0 + r;
            f32x4 xv[4];
#pragma unroll
            for (int j = 0; j < 4; ++j) xv[j] = *(const f32x4*)(xin + (size_t)row * D + 4 * F.lane + 256 * j);
            if (COMBINE) {
                f32x4 y[4];
#pragma unroll
                for (int j = 0; j < 4; ++j) y[j] = (f32x4){0.f, 0.f, 0.f, 0.f};
#pragma unroll
                for (int k = 0; k < TOPK; ++k) {
                    const int so = P_slot[row * 4 + k]; const float gt = P_gate[row * 4 + k];
                    const int e = so >> 14, pos = so & 16383; const size_t orow = (size_t)X[32 + e] * 256 + pos;
#pragma unroll
                    for (int j = 0; j < 4; ++j) { const u32x2 w = *(const u32x2*)(P_OB + orow * D + 4 * F.lane + 256 * j);
                        y[j] += gt * (f32x4){bflo(w.x), bfhi(w.x), bflo(w.y), bfhi(w.y)}; }
                }
#pragma unroll
                for (int j = 0; j < 4; ++j) { xv[j] += g2v[j] * y[j]; *(f32x4*)(P_out + (size_t)row * D + 4 * F.lane + 256 * j) = xv[j]; }
            }
            if (NORM) {
                float ss = 0.f;
#pragma unroll
                for (int j = 0; j < 4; ++j) ss += (xv[j][0] * xv[j][0] + xv[j][1] * xv[j][1]) + (xv[j][2] * xv[j][2] + xv[j][3] * xv[j][3]);
                const float rstd = __builtin_amdgcn_rsqf(wave_sum(ss) * (1.f / D) + EPS);
#pragma unroll
                for (int j = 0; j < 4; ++j) { const f32x4 h = xv[j] * rstd * a[j] + s[j]; u32x2 w; w.x = pk2(h[0], h[1]); w.y = pk2(h[2], h[3]);
                    *(u32x2*)(P_XN + (size_t)row * D + 4 * F.lane + 256 * j) = w; }
            }
        }
    }
}

__device__ __forceinline__ void argmax_wave(float& v, int& e) {
#pragma unroll
    for (int o = 32; o >= 1; o >>= 1) { const float ov = __shfl_xor(v, o); const int oe = __shfl_xor(e, o); if (ov > v || (ov == v && oe < e)) { v = ov; e = oe; } }
}
__device__ __forceinline__ void phase_router(Frame& F, const Args& A, int l) {
    LAS f32x4* rw = (LAS f32x4*)F.lds;
    LAS int* X = (LAS int*)(F.lds + XTR_OFF);
    { const f32x4* src = (const f32x4*)(P_rwT + (size_t)l * NE * D); for (int i = F.tid; i < NE * D / 4; i += NWAVES * 64) rw[i] = src[i]; }
    if (F.tid < NE) X[F.tid] = 0;
    __syncthreads();
    for (int rb = F.vcu; rb < M / 64; rb += F.G) {
        const int row0 = rb * 64 + F.wave * 8, b = row0 / SEQ;
        f32x4 a[4], s[4];
#pragma unroll
        for (int j = 0; j < 4; ++j) { const int c = 4 * F.lane + 256 * j; const f32x4 g = *(const f32x4*)(P_norm2_g + (size_t)l * D + c); const float* mp = P_mod + ((size_t)l * NB + b) * MODW;
            a[j] = g * (*(const f32x4*)(mp + 4 * D + c) + 1.0f); s[j] = *(const f32x4*)(mp + 3 * D + c); }
        for (int pr = 0; pr < 4; ++pr) {
            f32x4 h[2][4];
#pragma unroll
            for (int r = 0; r < 2; ++r) {
                const int row = row0 + 2 * pr + r;
                float ss = 0.f;
#pragma unroll
                for (int j = 0; j < 4; ++j) { h[r][j] = *(const f32x4*)(P_out + (size_t)row * D + 4 * F.lane + 256 * j); ss += (h[r][j][0] * h[r][j][0] + h[r][j][1] * h[r][j][1]) + (h[r][j][2] * h[r][j][2] + h[r][j][3] * h[r][j][3]); }
                const float rstd = __builtin_amdgcn_rsqf(wave_sum(ss) * (1.f / D) + EPS);
#pragma unroll
                for (int j = 0; j < 4; ++j) { h[r][j] = h[r][j] * rstd * a[j] + s[j]; u32x2 w; w.x = pk2(h[r][j][0], h[r][j][1]); w.y = pk2(h[r][j][2], h[r][j][3]);
                    *(u32x2*)(P_XN + (size_t)row * D + 4 * F.lane + 256 * j) = w; }
            }
            float t16[2][16];
            { const bool up32 = (F.lane & 32) != 0;
#pragma unroll
              for (int i = 0; i < 16; ++i) {
                float pl0 = 0.f, pl1 = 0.f, ph0 = 0.f, ph1 = 0.f;
#pragma unroll
                for (int j = 0; j < 4; ++j) { const f32x4 wl = rw[i * 256 + 64 * j + F.lane], wh = rw[(i + 16) * 256 + 64 * j + F.lane];
                    pl0 += (h[0][j][0] * wl[0] + h[0][j][1] * wl[1]) + (h[0][j][2] * wl[2] + h[0][j][3] * wl[3]);
                    pl1 += (h[1][j][0] * wl[0] + h[1][j][1] * wl[1]) + (h[1][j][2] * wl[2] + h[1][j][3] * wl[3]);
                    ph0 += (h[0][j][0] * wh[0] + h[0][j][1] * wh[1]) + (h[0][j][2] * wh[2] + h[0][j][3] * wh[3]);
                    ph1 += (h[1][j][0] * wh[0] + h[1][j][1] * wh[1]) + (h[1][j][2] * wh[2] + h[1][j][3] * wh[3]); }
                t16[0][i] = (up32 ? ph0 : pl0) + __shfl_xor(up32 ? pl0 : ph0, 32);
                t16[1][i] = (up32 ? ph1 : pl1) + __shfl_xor(up32 ? pl1 : ph1, 32);
                asm volatile("" ::: "memory"); __builtin_amdgcn_sched_barrier(0);
              } }
#pragma unroll
            for (int r = 0; r < 2; ++r) {
                float t8[8], t4[4], t2[2];
                { const bool up = (F.lane & 16) != 0;
#pragma unroll
                  for (int i = 0; i < 8; ++i) { const float lo = t16[r][i], hi = t16[r][i + 8]; t8[i] = (up ? hi : lo) + __shfl_xor(up ? lo : hi, 16); } }
                { const bool up = (F.lane & 8) != 0;
#pragma unroll
                  for (int i = 0; i < 4; ++i) { const float lo = t8[i], hi = t8[i + 4]; t4[i] = (up ? hi : lo) + __shfl_xor(up ? lo : hi, 8); } }
                { const bool up = (F.lane & 4) != 0;
#pragma unroll
                  for (int i = 0; i < 2; ++i) { const float lo = t4[i], hi = t4[i + 2]; t2[i] = (up ? hi : lo) + __shfl_xor(up ? lo : hi, 4); } }
                float v;
                { const bool up = (F.lane & 2) != 0; const float lo = t2[0], hi = t2[1]; v = (up ? hi : lo) + __shfl_xor(up ? lo : hi, 2); }
                v += __shfl_xor(v, 1);
                const int me = F.lane >> 1;
                v += P_router_b[l * NE + me];
                float tv[4]; int te[4]; float cv = v;
#pragma unroll
                for (int k = 0; k < 4; ++k) { float bv = cv; int be = me; argmax_wave(bv, be); tv[k] = bv; te[k] = be; if (me == be) cv = -3.0e38f; }
                const float e1 = __expf(tv[1] - tv[0]), e2 = __expf(tv[2] - tv[0]), e3 = __expf(tv[3] - tv[0]); const float inv = 1.0f / (1.0f + e1 + e2 + e3);
                if (F.lane < 4) {
                    const int my_e = F.lane == 0 ? te[0] : F.lane == 1 ? te[1] : F.lane == 2 ? te[2] : te[3];
                    const float my_g = (F.lane == 0 ? 1.0f : F.lane == 1 ? e1 : F.lane == 2 ? e2 : e3) * inv;
                    const int lr = __hip_atomic_fetch_add(&X[my_e], 1, __ATOMIC_RELAXED, __HIP_MEMORY_SCOPE_WORKGROUP);
                    const int rl = F.wave * 8 + 2 * pr + r;
                    X[64 + rl * 4 + F.lane] = my_e | (lr << 8);
                    P_gate[(size_t)(rb * 64 + rl) * 4 + F.lane] = my_g;
                }
            }
        }
        __syncthreads();
        if (F.tid < NE) X[32 + F.tid] = (int)__hip_atomic_fetch_add(F.ctl + CW_CNT + 64 * l + F.tid, (unsigned)X[F.tid], RLX_AGENT);
        __syncthreads();
        if (F.tid < 256) { const int rl = F.tid >> 2, sv = X[64 + F.tid], e = sv & 255, lr = sv >> 8, pos = X[32 + e] + lr, row = rb * 64 + rl;
            P_tok[e * M + pos] = row; P_slot[row * 4 + (F.tid & 3)] = (e << 14) | pos; }
        __syncthreads();
        if (F.tid < NE) X[F.tid] = 0;
        __syncthreads();
    }
}

__device__ __forceinline__ void phase_attn_naive(Frame& F, const Args& A, int l) {
    LAS unsigned char* kt = F.lds + F.wave * 16384;
    LAS float* bt = (LAS float*)(F.lds + XTR_OFF) + F.wave * 320;
    const int h = F.wave;
    __syncthreads();
    for (int i = F.lane; i < 257; i += 64) bt[i] = P_rel_bias[((size_t)l * NH + h) * 257 + i] * LOG2E;
    LDS_WAIT();
    const int hf = F.lane >> 5, d0 = 32 * hf;
    for (int un = F.vcu; un < NB * NCH; un += F.G) {
        const int b = un / NCH, n = un % NCH;
#pragma unroll 1
        for (int pass = 0; pass < 2; ++pass) {
            const int qi = 32 * pass + (F.lane & 31); const int qrow = b * SEQ + n * CHUNK + qi;
            float q[32], o[32];
            { const u32x4* qp = (const u32x4*)(P_QKVU + (size_t)qrow * INW + h * HD + d0);
#pragma unroll
              for (int c = 0; c < 4; ++c) { const u32x4 w = qp[c]; q[8 * c + 0] = bflo(w.x); q[8 * c + 1] = bfhi(w.x); q[8 * c + 2] = bflo(w.y); q[8 * c + 3] = bfhi(w.y); q[8 * c + 4] = bflo(w.z); q[8 * c + 5] = bfhi(w.z); q[8 * c + 6] = bflo(w.w); q[8 * c + 7] = bfhi(w.w); } }
#pragma unroll
            for (int d = 0; d < 32; ++d) o[d] = 0.f;
            float mrun = -1.0e30f, lrun = 0.f;
#pragma unroll 1
            for (int jj = (n >= LEFTC ? 0 : LEFTC - n); jj <= LEFTC; ++jj) {
                const int krow = b * SEQ + (n - LEFTC + jj) * CHUNK + F.lane;
                { const u32x4* kp = (const u32x4*)(P_QKVU + (size_t)krow * INW + AW + h * HD); const u32x4* vp = (const u32x4*)(P_QKVU + (size_t)krow * INW + 2 * AW + h * HD);
#pragma unroll
                  for (int c = 0; c < 8; ++c) { *(LAS u32x4*)(kt + F.lane * 128 + 16 * c) = kp[c]; *(LAS u32x4*)(kt + 8192 + F.lane * 128 + 16 * c) = vp[c]; } }
                LDS_WAIT(); asm volatile("" ::: "memory");
#pragma unroll 1
                for (int key = 0; key < 64; ++key) {
                    float acc = 0.f;
#pragma unroll
                    for (int c = 0; c < 4; ++c) { const u32x4 w = *(const LAS u32x4*)(kt + key * 128 + 2 * d0 + 16 * c);
                        acc += q[8 * c + 0] * bflo(w.x) + q[8 * c + 1] * bfhi(w.x) + q[8 * c + 2] * bflo(w.y) + q[8 * c + 3] * bfhi(w.y) + q[8 * c + 4] * bflo(w.z) + q[8 * c + 5] * bfhi(w.z) + q[8 * c + 6] * bflo(w.w) + q[8 * c + 7] * bfhi(w.w); }
                    acc += __shfl_xor(acc, 32);
                    int rel = (jj - LEFTC) * CHUNK + key - qi; rel = rel < -128 ? -128 : (rel > 128 ? 128 : rel);
                    const float sc = acc + bt[rel + 128];
                    const float mnew = fmaxf(mrun, sc), alpha = __builtin_amdgcn_exp2f(mrun - mnew), p = __builtin_amdgcn_exp2f(sc - mnew);
                    mrun = mnew; lrun = lrun * alpha + p;
#pragma unroll
                    for (int c = 0; c < 4; ++c) { const u32x4 w = *(const LAS u32x4*)(kt + 8192 + key * 128 + 2 * d0 + 16 * c);
                        o[8 * c + 0] = o[8 * c + 0] * alpha + p * bflo(w.x); o[8 * c + 1] = o[8 * c + 1] * alpha + p * bfhi(w.x); o[8 * c + 2] = o[8 * c + 2] * alpha + p * bflo(w.y); o[8 * c + 3] = o[8 * c + 3] * alpha + p * bfhi(w.y);
                        o[8 * c + 4] = o[8 * c + 4] * alpha + p * bflo(w.z); o[8 * c + 5] = o[8 * c + 5] * alpha + p * bfhi(w.z); o[8 * c + 6] = o[8 * c + 6] * alpha + p * bflo(w.w); o[8 * c + 7] = o[8 * c + 7] * alpha + p * bfhi(w.w); }
                }
                LDS_WAIT(); asm volatile("" ::: "memory");
            }
            const float il = 1.0f / lrun;
            { u32x4* op = (u32x4*)(P_MIX + (size_t)qrow * D + h * HD + d0);
#pragma unroll
              for (int c = 0; c < 4; ++c) { u32x4 w; w.x = pk2(o[8 * c + 0] * il, o[8 * c + 1] * il); w.y = pk2(o[8 * c + 2] * il, o[8 * c + 3] * il); w.z = pk2(o[8 * c + 4] * il, o[8 * c + 5] * il); w.w = pk2(o[8 * c + 6] * il, o[8 * c + 7] * il); op[c] = w; } }
        }
    }
    __syncthreads();
}
__device__ __forceinline__ void phase_pool_naive(Frame& F, const Args& A, int l) {
    LAS float* dl = (LAS float*)F.lds;
    __syncthreads();
    for (int un = F.vcu; un < (M / 64) * 4; un += F.G) {
        const int rb = un >> 2, g = un & 3, w = 2 << g;
        { const int c = F.tid & 127, r0 = F.tid >> 7;
          for (int i = 0; i < 16; ++i) { const int r = r0 + 4 * i, row = rb * 64 + r, tpos = row % SEQ; const int cnt = (tpos + 1) < w ? (tpos + 1) : w;
              float sum = 0.f; for (int s = 0; s < cnt; ++s) sum += bflo((unsigned)P_QKVU[(size_t)(row - s) * INW + 3 * AW + g * PGRP + c]);
              const float ut = bflo((unsigned)P_QKVU[(size_t)row * INW + 3 * AW + g * PGRP + c]);
              dl[r * 129 + c] = sum / (float)cnt - ut; } }
        __syncthreads();
        { const int j = F.tid & 127, rq = F.tid >> 7; float acc[16];
#pragma unroll
          for (int i = 0; i < 16; ++i) acc[i] = 0.f;
          const float* pw = P_pool_w + ((size_t)(l * 4 + g) * PGRP) * PGRP + j;
          for (int c = 0; c < PGRP; ++c) { const float wv = pw[(size_t)c * PGRP];
#pragma unroll
              for (int i = 0; i < 16; ++i) acc[i] += dl[(rq + 4 * i) * 129 + c] * wv; }
          const float pb = P_pool_b[l * 512 + g * PGRP + j], ps = P_pool_scale[l * 512 + g * PGRP + j];
#pragma unroll
          for (int i = 0; i < 16; ++i) P_MIX[(size_t)(rb * 64 + rq + 4 * i) * D + AW + g * PGRP + j] = (bf16)f2bf((acc[i] + pb) * ps); }
        __syncthreads();
    }
}

constexpr int NSTEP = 1 + 7 * DEPTH + 1;

__global__ void __launch_bounds__(NWAVES * 64, 2) mk_fwd(Args args) {
    const Args& A = args;
    extern __shared__ __attribute__((aligned(16))) unsigned char lds[];
    Frame F;
    F.lds = (LAS unsigned char*)lds;
    F.MISC = (volatile LAS unsigned*)(F.lds + LDSCTL_OFF);
    F.tid = threadIdx.x; F.lane = F.tid & 63; F.wave = __builtin_amdgcn_readfirstlane(F.tid >> 6);
    F.G = gridDim.x; { const int bx = blockIdx.x; F.vcu = (F.G % 8 == 0) ? (bx % 8) * (F.G / 8) + bx / 8 : bx; }
    unsigned char* ws = args.ws;
    F.ctl = (gu32*)(ws + WS_CTL);
    for (int u = F.tid; u < 128; u += NWAVES * 64) ((LAS unsigned*)(F.lds + LDSCTL_OFF))[u] = 0u;
    __syncthreads();
    XcdBarrier bar; bar.bar = (unsigned*)(F.ctl + CW_BAR); bar.x = 0; bar.st = nullptr;
    const int lo = args.s_lo, hi = args.s_hi;
    if (hi - lo > 1) bar = xcd_barrier_post((unsigned*)(F.ctl + CW_BAR), F.MISC + 8);
#define IN(k) (lo <= (k) && (k) < hi)
#define OPAQUE() do { asm volatile("" : "+v"(F.tid)); F.lane = F.tid & 63; F.wave = __builtin_amdgcn_readfirstlane(F.tid >> 6); } while (0)
#define SEAM(k) do { if (IN(k) && IN((k) + 1)) xcd_barrier(bar); } while (0)

    if (IN(0)) { OPAQUE(); p0_mod(F, args); p0_convert(F, args); SEAM(0); }

    for (int l = 0; l < DEPTH; ++l) {
        const int sb = 1 + 7 * l;
        if (IN(sb + 0)) { OPAQUE(); if (l == 0) phase_cn<false, true>(F, args, l); else phase_cn<true, true>(F, args, l); SEAM(sb + 0); }
        if (IN(sb + 1)) { OPAQUE();
            pg8::DenseOrder S; S.init(M, INW, F.G, (int)blockIdx.x, P_XN, P_WIN + (size_t)l * INW * D);
            pg8::EpiWin E{P_QKVU, P_q_g + l * HD, P_k_g + l * HD};
            pg8::gemm_phase<pg8::EpiWin, pg8::DenseOrder, false>(F.lds + RING_OFF, S, E);
            SEAM(sb + 1);
        }
        if (IN(sb + 2)) { OPAQUE(); phase_attn_naive(F, args, l); OPAQUE(); phase_pool_naive(F, args, l); SEAM(sb + 2); }
        if (IN(sb + 3)) { OPAQUE();
            pg8::DenseOrder S; S.init(M, D, F.G, (int)blockIdx.x, P_MIX, P_WOUT + (size_t)l * D * D);
            pg8::EpiWout E{l == 0 ? P_x : P_out, P_out, P_mod + (size_t)l * NB * MODW + 2 * D};
            pg8::gemm_phase<pg8::EpiWout, pg8::DenseOrder, false>(F.lds + RING_OFF, S, E);
            SEAM(sb + 3);
        }
        if (IN(sb + 4)) { OPAQUE(); phase_router(F, args, l); SEAM(sb + 4); }
        if (IN(sb + 5)) { OPAQUE();
            const int T = moe_tables(F, l);
            LAS int* X = (LAS int*)(F.lds + XTR_OFF);
            pg8::MoeOrder S; S.tile_e = X + 128; S.toff = (const LAS unsigned*)(X + 512); S.T = T; S.vcu = F.vcu; S.G = F.G; S.ncol = 8; S.rpb = 4;
            S.A = (const char*)P_XN; S.B = (const char*)(P_W1 + (size_t)l * NE * 2048 * D); S.estride = (size_t)2048 * D * 2; S.gather = true;
            { pg8::GUnit u; for (int i = 0; i < MAXU && S.next(i, u); ++i) { if (F.tid < 256) { const int e = u.e, base = u.row0 - X[32 + e] * 256 + F.tid, cnt = X[e]; const int idx = base < cnt ? base : cnt - 1;
                    ((LAS unsigned*)(X + 512))[i * 256 + F.tid] = (unsigned)P_tok[e * M + idx] * (unsigned)(D * 2); } } }
            __syncthreads();
            pg8::EpiSwiglu E{P_H, P_exp_b1 + (size_t)l * NE * 2048};
            pg8::gemm_phase<pg8::EpiSwiglu, pg8::MoeOrder, true>(F.lds + RING_OFF, S, E);
            SEAM(sb + 5);
        }
        if (IN(sb + 6)) { OPAQUE();
            const int T = moe_tables(F, l);
            LAS int* X = (LAS int*)(F.lds + XTR_OFF);
            pg8::MoeOrder S; S.tile_e = X + 128; S.toff = (const LAS unsigned*)(X + 512); S.T = T; S.vcu = F.vcu; S.G = F.G; S.ncol = 4; S.rpb = 8;
            S.A = (const char*)P_H; S.B = (const char*)(P_W2 + (size_t)l * NE * D * FE); S.estride = (size_t)D * FE * 2; S.gather = false;
            pg8::EpiOB E{P_OB, P_exp_b2 + (size_t)l * NE * D};
            pg8::gemm_phase<pg8::EpiOB, pg8::MoeOrder, false>(F.lds + RING_OFF, S, E);
            SEAM(sb + 6);
        }
    }
    if (IN(NSTEP - 1)) { OPAQUE(); phase_cn<true, false>(F, args, DEPTH); }
#undef IN
#undef OPAQUE
#undef SEAM
}

extern "C" void kernel_launch(void* const* d_in, const int* in_sizes, int n_in, void* d_out, int out_size, void* d_ws, size_t ws_size, hipStream_t stream) {
    static int grid = 0;
    if (grid == 0) {
        if (n_in != 20 || in_sizes[0] != M * D || out_size != M * D || ws_size < WS_END) { fprintf(stderr, "kernel_launch: unexpected shapes / workspace (n_in %d, ws %zu)\n", n_in, ws_size); grid = -1; return; }
        int dev = 0, cus = 0, per_cu = 0;
        if (hipGetDevice(&dev) != hipSuccess || hipDeviceGetAttribute(&cus, hipDeviceAttributeMultiprocessorCount, dev) != hipSuccess) { grid = -1; return; }
        if (hipFuncSetAttribute((const void*)mk_fwd, hipFuncAttributeMaxDynamicSharedMemorySize, LDS_BYTES) != hipSuccess) { fprintf(stderr, "kernel_launch: hipFuncSetAttribute failed\n"); grid = -1; return; }
        if (hipOccupancyMaxActiveBlocksPerMultiprocessor(&per_cu, (const void*)mk_fwd, NWAVES * 64, LDS_BYTES) != hipSuccess || per_cu < 1) fprintf(stderr, "kernel_launch: occupancy query reports %d\n", per_cu);
        (void)hipGetLastError();
        grid = cus;
    }
    if (grid < 0) return;
    if (hipMemsetAsync((char*)d_ws + WS_CTL, 0, CTL_ZERO_BYTES, stream) != hipSuccess) return;
    Args a{};
    for (int i = 0; i < 20; ++i) a.in[i] = (const float*)d_in[i];
    a.out = (float*)d_out; a.ws = (unsigned char*)d_ws;
#if MK_ONE_LAUNCH
    a.s_lo = 0; a.s_hi = NSTEP;
    hipLaunchKernelGGL(mk_fwd, dim3(grid), dim3(NWAVES * 64), LDS_BYTES, stream, a);
#else
    for (int s = 0; s < NSTEP; ++s) { a.s_lo = s; a.s_hi = s + 1; hipLaunchKernelGGL(mk_fwd, dim3(grid), dim3(NWAVES * 64), LDS_BYTES, stream, a); }
#endif
}
```

```cpp
#include <hip/hip_runtime.h>
#include <cstdio>
#include <cstdint>

#ifndef ATTN_NAIVE
#define ATTN_NAIVE 0
#endif
#ifndef POOL_NAIVE
#define POOL_NAIVE 0
#endif
#ifndef MK_ONE_LAUNCH
#define MK_ONE_LAUNCH 1
#endif

#define GAS __attribute__((address_space(1)))
#define LAS __attribute__((address_space(3)))
typedef unsigned short bf16;
typedef unsigned u32x4 __attribute__((ext_vector_type(4)));
typedef unsigned u32x2 __attribute__((ext_vector_type(2)));
typedef float f32x4 __attribute__((ext_vector_type(4)));
typedef float f32x2 __attribute__((ext_vector_type(2)));
typedef short bf16x8 __attribute__((ext_vector_type(8)));
typedef GAS unsigned gu32;

constexpr int NB = 4, SEQ = 4096, D = 1024, M = NB * SEQ, DEPTH = 4;
constexpr int CHUNK = 64, NCH = SEQ / CHUNK, LEFTC = 8;
constexpr int NH = 8, HD = 64, AW = 512, PGRP = 128, INW = 2048;
constexpr int NE = 32, TOPK = 4, FE = 1024;
constexpr int MAXT = 288;
constexpr int MAXU = 9;
constexpr float EPS = 1e-6f;
constexpr float LOG2E = 1.4426950408889634f;
constexpr int MODW = 6 * D;

constexpr size_t MiB = 1u << 20;
constexpr size_t WS_CTL = 0, CTL_ZERO_BYTES = 1 * MiB;
constexpr size_t WS_MOD = 1 * MiB;
constexpr size_t WS_RWT = 2 * MiB;
constexpr size_t WS_GATE = 3 * MiB;
constexpr size_t WS_SLOT = 3 * MiB + 512 * 1024;
constexpr size_t WS_TOK = 4 * MiB;
constexpr size_t WS_PWT = 6 * MiB;
constexpr size_t WS_WIN = 8 * MiB;
constexpr size_t WS_WOUT = 24 * MiB;
constexpr size_t WS_XN = 32 * MiB;
constexpr size_t WS_QKVU = 64 * MiB;
constexpr size_t WS_MIX = 128 * MiB;
constexpr size_t WS_H = 160 * MiB;
constexpr size_t WS_OB = 304 * MiB;
constexpr size_t WS_W1 = 448 * MiB;
constexpr size_t WS_W2 = 960 * MiB;
constexpr size_t WS_END = 1216 * MiB;
constexpr int CW_TMO = 0, CW_CODE = 1;
constexpr int CW_BAR = 4096;
constexpr int CW_CNT = 16384;

constexpr int RING_OFF = 0, RING_BYTES = 131072;
constexpr int LDSCTL_OFF = RING_BYTES;
constexpr int XTR_OFF = RING_BYTES + 512;
constexpr int LDS_BYTES = 147456;
constexpr int XTR_BYTES = LDS_BYTES - XTR_OFF;

#define RLX_AGENT __ATOMIC_RELAXED, __HIP_MEMORY_SCOPE_AGENT
#define LDS_WAIT() asm volatile("s_waitcnt lgkmcnt(0)" ::: "memory")
#define VM_WAIT() asm volatile("s_waitcnt vmcnt(0)" ::: "memory")
__device__ __forceinline__ unsigned f2bf(float f) { unsigned u = __builtin_bit_cast(unsigned, f); return (u + 0x7fffu + ((u >> 16) & 1u)) >> 16; }
__device__ __forceinline__ unsigned pk2(float lo, float hi) { return f2bf(lo) | (f2bf(hi) << 16); }
__device__ __forceinline__ unsigned cvt_pk_bf16(float lo, float hi) { unsigned r; asm volatile("v_cvt_pk_bf16_f32 %0, %1, %2" : "=v"(r) : "v"(lo), "v"(hi)); return r; }
__device__ __forceinline__ float bflo(unsigned u) { return __builtin_bit_cast(float, u << 16); }
__device__ __forceinline__ float bfhi(unsigned u) { return __builtin_bit_cast(float, u & 0xffff0000u); }
__device__ __forceinline__ float wave_sum(float v) {
#pragma unroll
    for (int o = 1; o < 64; o <<= 1) v += __shfl_xor(v, o);
    return v;
}

#define XB_TMO      128
#define XB_XCNT(j)  (256  + 64 * (j))
#define XB_XSUB(j)  (1280 + 64 * (j))
#define XB_XGEN(j)  (2304 + 64 * (j))
#define XB_TOP      3328
#define XB_TOPGEN   3392
#define XCD_BAR_WORDS 3456
#define XB_SPIN_CAP (1u << 18)
__device__ __forceinline__ unsigned xb_ld(unsigned* p)              { return __hip_atomic_load(p, __ATOMIC_RELAXED, __HIP_MEMORY_SCOPE_AGENT); }
__device__ __forceinline__ unsigned xb_add(unsigned* p, unsigned v) { return __hip_atomic_fetch_add(p, v, __ATOMIC_RELAXED, __HIP_MEMORY_SCOPE_AGENT); }
__device__ __forceinline__ unsigned xb_xcc_id() { return (unsigned)__builtin_amdgcn_s_getreg((3 << 11) | 20) & 0xFu; }
#define XB_SPIN(cond, bar) do { unsigned _sp = 0; while (cond) { __builtin_amdgcn_s_sleep(1); \
    if ((++_sp & 255u) == 0u) { if (xb_ld(&(bar)[XB_TMO])) break; if (_sp > XB_SPIN_CAP) { atomicAdd(&(bar)[XB_TMO], 1u); break; } } } } while (0)
struct XcdBarrier { unsigned* bar; unsigned x; volatile LAS unsigned* st; };
__device__ __forceinline__ XcdBarrier xcd_barrier_post(unsigned* bar, volatile LAS unsigned* st) {
    XcdBarrier b; b.bar = bar; b.x = xb_xcc_id(); b.st = st;
    if (threadIdx.x == 0) (void)xb_add(&bar[XB_XCNT(b.x)], 1u);
    return b;
}
__device__ __forceinline__ void xcd_barrier_complete(unsigned* bar, unsigned x, unsigned& nloc, unsigned& nx) {
    const unsigned G = gridDim.x * gridDim.y * gridDim.z;
    unsigned sum, cnt, mine, sp = 0u;
    for (;;) {
        sum = 0u; cnt = 0u; mine = 0u;
#pragma unroll
        for (unsigned j = 0; j < 16; ++j) { const unsigned c = xb_ld(&bar[XB_XCNT(j)]); sum += c; cnt += (c > 0u) ? 1u : 0u; mine = (j == x) ? c : mine; }
        if (sum == G) break;
        __builtin_amdgcn_s_sleep(1);
        if ((++sp & 255u) == 0u) { if (xb_ld(&bar[XB_TMO])) break; if (sp > XB_SPIN_CAP) { atomicAdd(&bar[XB_TMO], 1u); break; } }
    }
    nloc = mine > 0u ? mine : 1u; nx = cnt > 0u ? cnt : 1u;
}
__device__ __forceinline__ void xcd_barrier(const XcdBarrier& b) {
    asm volatile("s_waitcnt vmcnt(0)" ::: "memory");
    __syncthreads();
    if (threadIdx.x == 0) {
        unsigned* bar = b.bar;
        __builtin_amdgcn_s_waitcnt(0);
        unsigned nloc = b.st[0], nx = b.st[1];
        if (nloc == 0u) { xcd_barrier_complete(bar, b.x, nloc, nx); b.st[0] = nloc; b.st[1] = nx; }
        const unsigned old = xb_add(&bar[XB_XSUB(b.x)], 1u);
        const unsigned gen = old / nloc;
        if (old + 1u == (gen + 1u) * nloc) {
            __builtin_amdgcn_fence(__ATOMIC_RELEASE, "agent");
            asm volatile("s_waitcnt vmcnt(0)" ::: "memory");
            const unsigned og = xb_add(&bar[XB_TOP], 1u);
            const unsigned tg = og / nx;
            if (og + 1u == (tg + 1u) * nx) xb_add(&bar[XB_TOPGEN], 1u);
            else XB_SPIN(xb_ld(&bar[XB_TOPGEN]) == tg, bar);
            __builtin_amdgcn_fence(__ATOMIC_ACQUIRE, "agent");
            xb_add(&bar[XB_XGEN(b.x)], 1u);
            asm volatile("s_waitcnt vmcnt(0)" ::: "memory");
        } else {
            XB_SPIN(xb_ld(&bar[XB_XGEN(b.x)]) == gen, bar);
            __builtin_amdgcn_fence(__ATOMIC_ACQUIRE, "agent");
            asm volatile("s_waitcnt vmcnt(0)" ::: "memory");
        }
    }
    __syncthreads();
}

namespace pg8 {
constexpr int BM = 256, BK = 64, HALF = 128, HTB = HALF * BK * 2, STAGE_BYTES = 8 * HTB, NXCD = 8, WGM = 8, KD = 1024;
constexpr size_t KSTEP = (size_t)BK * 2, HSTEP = (size_t)HALF * KD * 2, TSTEP = 2 * HSTEP;
__host__ __device__ __forceinline__ int lds_byte(int r, int c) { const int st = (r >> 4) * 2 + (c >> 5), rr = r & 15, cc = c & 31, ob = rr * 64 + cc * 2; return st * 1024 + (ob ^ (((ob >> 9) & 1) << 5)); }
__host__ __device__ __forceinline__ void stage_rc(int b, int& R, int& C) { const int st = b / 1024, sb = b % 1024, swz = sb ^ (((sb >> 9) & 1) << 5); R = (st >> 1) * 16 + swz / 64; C = (st & 1) * 32 + (swz % 64) / 2; }
__host__ __device__ __forceinline__ int perm32(int rho) { const int n = rho >> 4, i = rho & 15; return 8 * (i >> 2) + 4 * n + (i & 3); }

struct GUnit { const char* A; const char* B; int row0; int pn; int e; int li; };

struct DenseOrder {
    int nM, nN, nwg, G, c; const char* A; const char* B;
    __device__ __forceinline__ void init(int M_, int N_, int G_, int c_, const void* A_, const void* B_) { nM = M_ / BM; nN = N_ / BM; nwg = nM * nN; G = G_; c = c_; A = (const char*)A_; B = (const char*)B_; }
    __device__ __forceinline__ bool next(int i, GUnit& u) const {
        const long L = (long)i * G + c; if (L >= nwg) return false;
        int wgid = (int)L; { const int q = nwg / NXCD, r = nwg % NXCD, xcd = wgid % NXCD, off = wgid / NXCD; wgid = (xcd < r ? xcd * (q + 1) : r * (q + 1) + (xcd - r) * q) + off; }
        const int nig = WGM * nN, gid = wgid / nig, fm = gid * WGM, gsz = (nM - fm) < WGM ? (nM - fm) : WGM;
        const int pm = fm + ((wgid % nig) % gsz), pn = (wgid % nig) / gsz;
        u.A = A + (size_t)pm * TSTEP; u.B = B + (size_t)pn * TSTEP; u.row0 = pm * BM; u.pn = pn; u.e = 0; u.li = i; return true;
    }
    __device__ __forceinline__ unsigned tokoff(int, int) const { return 0u; }
};
struct MoeOrder {
    const LAS int* tile_e; const LAS unsigned* toff;
    int T, vcu, G, ncol, rpb; const char* A; const char* B; size_t estride; bool gather;
    __device__ __forceinline__ bool next(int i, GUnit& u) const {
        const int uu = vcu + i * G; if (uu >= T * ncol) return false;
        const int blk = uu >> 5, j = uu & 31; int tib = T - blk * rpb; tib = tib > rpb ? rpb : tib;
        const int tile = blk * rpb + j % tib, pn = j / tib;
        const int e = __builtin_amdgcn_readfirstlane(tile_e[tile]);
        u.row0 = tile * BM; u.pn = pn; u.e = e; u.li = i;
        u.A = gather ? A : A + (size_t)tile * TSTEP; u.B = B + (size_t)e * estride + (size_t)pn * TSTEP; return true;
    }
    __device__ __forceinline__ unsigned tokoff(int li, int r) const { return toff[li * 256 + r]; }
};

typedef f32x4 Acc[2][2][4][2];

struct EpiWin {
    static constexpr bool PERM = true;
    bf16* O; const float* qg; const float* kg;
    __device__ __forceinline__ void operator()(const Acc& acc, const GUnit& u, int wr, int wc, int fr, int fq) const {
        const int kind = u.pn >> 1;
        const int col0 = u.pn * 256 + 64 * wc + 8 * fq;
        f32x4 gv[2][2];
#pragma unroll
        for (int bj = 0; bj < 2; ++bj)
#pragma unroll
            for (int n = 0; n < 2; ++n) {
                const int d = 32 * bj + 8 * fq + 4 * n;
                if (kind == 0) gv[bj][n] = *(const f32x4*)(qg + d) * (0.125f * LOG2E);
                else if (kind == 1) gv[bj][n] = *(const f32x4*)(kg + d);
                else gv[bj][n] = (f32x4){1.f, 1.f, 1.f, 1.f};
            }
#pragma unroll
        for (int ai = 0; ai < 2; ++ai)
#pragma unroll
            for (int m = 0; m < 4; ++m) {
                const int row = u.row0 + ai * HALF + wr * 64 + m * 16 + fr;
                float rstd = 1.f;
                if (kind < 2) {
                    float ss = 0.f;
#pragma unroll
                    for (int bj = 0; bj < 2; ++bj)
#pragma unroll
                        for (int n = 0; n < 2; ++n) { const f32x4 x = acc[ai][bj][m][n]; ss += (x[0] * x[0] + x[1] * x[1]) + (x[2] * x[2] + x[3] * x[3]); }
                    ss += __shfl_xor(ss, 16); ss += __shfl_xor(ss, 32);
                    rstd = __builtin_amdgcn_rsqf(ss * (1.f / 64.f) + EPS);
                }
                bf16* rowp = O + (size_t)row * INW + col0;
#pragma unroll
                for (int bj = 0; bj < 2; ++bj) {
                    const f32x4 v0 = acc[ai][bj][m][0] * rstd * gv[bj][0], v1 = acc[ai][bj][m][1] * rstd * gv[bj][1];
                    u32x4 w; w.x = cvt_pk_bf16(v0[0], v0[1]); w.y = cvt_pk_bf16(v0[2], v0[3]); w.z = cvt_pk_bf16(v1[0], v1[1]); w.w = cvt_pk_bf16(v1[2], v1[3]);
                    *(u32x4*)(rowp + 32 * bj) = w;
                }
            }
    }
};
struct EpiWout {
    static constexpr bool PERM = false;
    const float* xin; float* xout; const float* g1;
    __device__ __forceinline__ void operator()(const Acc& acc, const GUnit& u, int wr, int wc, int fr, int fq) const {
        const int b = u.row0 / SEQ; const int col0 = u.pn * BM + wc * 32 + 4 * fq;
        f32x4 gv[2][2];
#pragma unroll
        for (int bj = 0; bj < 2; ++bj)
#pragma unroll
            for (int n = 0; n < 2; ++n) gv[bj][n] = *(const f32x4*)(g1 + (size_t)b * MODW + col0 + bj * HALF + n * 16);
#pragma unroll
        for (int ai = 0; ai < 2; ++ai)
#pragma unroll
            for (int m = 0; m < 4; ++m) {
                const size_t off = (size_t)(u.row0 + ai * HALF + wr * 64 + m * 16 + fr) * D + col0;
#pragma unroll
                for (int bj = 0; bj < 2; ++bj)
#pragma unroll
                    for (int n = 0; n < 2; ++n) { const f32x4 xv = *(const f32x4*)(xin + off + bj * HALF + n * 16); *(f32x4*)(xout + off + bj * HALF + n * 16) = xv + gv[bj][n] * acc[ai][bj][m][n]; }
                if (m & 1) asm volatile("" ::: "memory");
            }
    }
};
struct EpiSwiglu {
    static constexpr bool PERM = true;
    bf16* H; const float* b1;
    __device__ __forceinline__ void operator()(const Acc& acc, const GUnit& u, int wr, int wc, int fr, int fq) const {
        const int j0 = u.pn * 128 + wc * 32 + 8 * fq; const float* be = b1 + (size_t)u.e * 2048 + j0;
        f32x4 bg[2], bl[2];
#pragma unroll
        for (int n = 0; n < 2; ++n) { bg[n] = *(const f32x4*)(be + 4 * n); bl[n] = *(const f32x4*)(be + 1024 + 4 * n); }
#pragma unroll
        for (int ai = 0; ai < 2; ++ai)
#pragma unroll
            for (int m = 0; m < 4; ++m) {
                bf16* rowp = H + (size_t)(u.row0 + ai * HALF + wr * 64 + m * 16 + fr) * FE + j0;
                float o[8];
#pragma unroll
                for (int n = 0; n < 2; ++n)
#pragma unroll
                    for (int i = 0; i < 4; ++i) {
                        float g = acc[ai][0][m][n][i] + bg[n][i], l = acc[ai][1][m][n][i] + bl[n][i];
                        g = fminf(g, 7.0f); l = fminf(fmaxf(l, -7.0f), 7.0f);
                        const float sg = __builtin_amdgcn_rcpf(1.0f + __builtin_amdgcn_exp2f(-1.702f * LOG2E * g));
                        o[4 * n + i] = g * sg * (l + 1.0f);
                    }
                u32x4 w; w.x = cvt_pk_bf16(o[0], o[1]); w.y = cvt_pk_bf16(o[2], o[3]); w.z = cvt_pk_bf16(o[4], o[5]); w.w = cvt_pk_bf16(o[6], o[7]);
                *(u32x4*)rowp = w;
            }
    }
};
struct EpiOB {
    static constexpr bool PERM = true;
    bf16* O; const float* b2;
    __device__ __forceinline__ void operator()(const Acc& acc, const GUnit& u, int wr, int wc, int fr, int fq) const {
        const int col0 = u.pn * BM + wc * 32 + 8 * fq; const float* be = b2 + (size_t)u.e * D + col0;
        f32x4 bv[2][2];
#pragma unroll
        for (int bj = 0; bj < 2; ++bj)
#pragma unroll
            for (int n = 0; n < 2; ++n) bv[bj][n] = *(const f32x4*)(be + bj * HALF + 4 * n);
#pragma unroll
        for (int ai = 0; ai < 2; ++ai)
#pragma unroll
            for (int m = 0; m < 4; ++m) {
                bf16* rowp = O + (size_t)(u.row0 + ai * HALF + wr * 64 + m * 16 + fr) * D + col0;
#pragma unroll
                for (int bj = 0; bj < 2; ++bj) {
                    const f32x4 v0 = acc[ai][bj][m][0] + bv[bj][0], v1 = acc[ai][bj][m][1] + bv[bj][1];
                    u32x4 w; w.x = cvt_pk_bf16(v0[0], v0[1]); w.y = cvt_pk_bf16(v0[2], v0[3]); w.z = cvt_pk_bf16(v1[0], v1[1]); w.w = cvt_pk_bf16(v1[2], v1[3]);
                    *(u32x4*)(rowp + bj * HALF) = w;
                }
            }
    }
};

template <class Epi, class Sched, bool GATHER>
__device__ __forceinline__ void gemm_phase(LAS unsigned char* lds, const Sched& S, const Epi& E) {
    int tid_ = threadIdx.x; asm volatile("" : "+v"(tid_));
    const int tid = tid_, wid = __builtin_amdgcn_readfirstlane(tid >> 6), lane = tid & 63, wr = wid >> 2, wc = wid & 3, fr = lane & 15, fq = lane >> 4;
    constexpr int K = KD, nt = K / BK;
    unsigned voffA[2], voffB[2]; int RA[2]; unsigned CA[2];
#pragma unroll
    for (int i = 0; i < 2; ++i) { int R, C; stage_rc(tid * 16 + i * 8192, R, C); const int Rb = Epi::PERM ? ((R & ~31) + perm32(R & 31)) : R;
        voffA[i] = (unsigned)(R * K + C) * 2u; voffB[i] = (unsigned)(Rb * K + C) * 2u; RA[i] = R; CA[i] = (unsigned)C * 2u; }
    constexpr size_t kstep = KSTEP, hstep = HSTEP;
    const unsigned ldsw = (unsigned)wid * 1024u;
    const int aoff = lds_byte(wr * 64 + fr, fq * 8), boff = lds_byte(wc * 32 + fr, fq * 8);
#define PG8_SA(b, h) (((b) * 2 + (h)) * HTB)
#define PG8_SB(b, h) ((4 + (b) * 2 + (h)) * HTB)
#define PG8_STAGE(bufoff, gbase, voff) do { _Pragma("unroll") for (int _i = 0; _i < 2; ++_i) \
        __builtin_amdgcn_global_load_lds((const unsigned*)((const char*)(gbase) + (voff)[_i]), (LAS unsigned*)(lds + (bufoff) + ldsw + _i * 8192), 16, 0, 0); } while (0)
#define PG8_STAGE_A(bufoff, base, h, V) do { if constexpr (GATHER) { PG8_STAGE(bufoff, base, (V)[h]); } else { PG8_STAGE(bufoff, (base) + (h) * hstep, voffA); } } while (0)
#define PG8_LDA(dst, b, h) do { _Pragma("unroll") for (int m = 0; m < 4; ++m) _Pragma("unroll") for (int k = 0; k < 2; ++k) dst[m][k] = *(const LAS bf16x8*)(lds + PG8_SA(b, h) + aoff + m * 2048 + k * 1024); } while (0)
#define PG8_LDB(dst, b, h) do { _Pragma("unroll") for (int n = 0; n < 2; ++n) _Pragma("unroll") for (int k = 0; k < 2; ++k) dst[n][k] = *(const LAS bf16x8*)(lds + PG8_SB(b, h) + boff + n * 2048 + k * 1024); } while (0)
#define PG8_MMA(ai, bj, At, Bt) do { __builtin_amdgcn_s_setprio(1); _Pragma("unroll") for (int m = 0; m < 4; ++m) _Pragma("unroll") for (int n = 0; n < 2; ++n) _Pragma("unroll") for (int k = 0; k < 2; ++k) \
        acc[ai][bj][m][n] = __builtin_amdgcn_mfma_f32_16x16x32_bf16(Bt[n][k], At[m][k], acc[ai][bj][m][n], 0, 0, 0); __builtin_amdgcn_s_setprio(0); } while (0)
#define PG8_WAIT_V(n) asm volatile("s_waitcnt vmcnt(" #n ")" ::: "memory")
#define PG8_WAIT_L(n) asm volatile("s_waitcnt lgkmcnt(" #n ")" ::: "memory")
#define PG8_BAR __builtin_amdgcn_s_barrier()
#define PG8_SCHED __builtin_amdgcn_sched_barrier(0)
#define PG8_AOFF(V, U) do { if constexpr (GATHER) { _Pragma("unroll") for (int _h = 0; _h < 2; ++_h) _Pragma("unroll") for (int _i = 0; _i < 2; ++_i) (V)[_h][_i] = S.tokoff((U).li, _h * HALF + RA[_i]) + CA[_i]; } } while (0)
    GUnit cur, nxt; int ui = 0;
    if (!S.next(0, cur)) return;
    Acc acc;
#pragma unroll
    for (int a = 0; a < 2; ++a)
#pragma unroll
        for (int b = 0; b < 2; ++b)
#pragma unroll
            for (int m = 0; m < 4; ++m)
#pragma unroll
                for (int n = 0; n < 2; ++n) acc[a][b][m][n] = (f32x4){0.f, 0.f, 0.f, 0.f};
    bf16x8 At[4][2], B0[2][2], B1[2][2];
    unsigned va[2][2] = {{0u, 0u}, {0u, 0u}};
    const char* cA = cur.A; const char* cB = cur.B;
    PG8_AOFF(va, cur);
    PG8_STAGE(PG8_SB(0, 0), cB, voffB); PG8_STAGE(PG8_SB(0, 1), cB + hstep, voffB); PG8_STAGE_A(PG8_SA(0, 0), cA, 0, va); PG8_STAGE_A(PG8_SA(0, 1), cA, 1, va);
    if (wr == 1) PG8_BAR;
    PG8_WAIT_V(2); PG8_BAR;
    PG8_STAGE(PG8_SB(1, 0), cB + kstep, voffB); PG8_STAGE_A(PG8_SA(1, 0), cA + kstep, 0, va); PG8_STAGE(PG8_SB(1, 1), cB + hstep + kstep, voffB);
    PG8_WAIT_V(6); PG8_BAR;
    for (;;) {
        const bool has_next = S.next(ui + 1, nxt);
        const char* nA = has_next ? nxt.A : cA; const char* nB = has_next ? nxt.B : cB;
        for (int t = 0; t < nt; t += 2) {
            const bool last = (t == nt - 2);
            const char* a1 = cA + (size_t)(t + 1) * kstep;
            const char* a2 = last ? nA : cA + (size_t)(t + 2) * kstep; const char* b2 = last ? nB : cB + (size_t)(t + 2) * kstep;
            const char* a3 = a2 + kstep; const char* b3 = b2 + kstep;
            PG8_LDB(B0, 0, 0); PG8_LDB(B1, 0, 1); PG8_SCHED; PG8_LDA(At, 0, 0); PG8_STAGE_A(PG8_SA(1, 1), a1, 1, va);
            if constexpr (GATHER) { if (last && has_next) { PG8_AOFF(va, nxt); } }
            PG8_WAIT_V(8); PG8_WAIT_L(0); PG8_BAR; PG8_MMA(0, 0, At, B0); PG8_MMA(0, 1, At, B1); PG8_BAR; PG8_SCHED;
            PG8_LDA(At, 0, 1); PG8_STAGE(PG8_SB(0, 0), b2, voffB); PG8_STAGE(PG8_SB(0, 1), b2 + hstep, voffB); PG8_STAGE_A(PG8_SA(0, 0), a2, 0, va);
            PG8_WAIT_V(8); PG8_WAIT_L(0); PG8_BAR; PG8_MMA(1, 0, At, B0); PG8_MMA(1, 1, At, B1); PG8_BAR; PG8_SCHED;
            PG8_LDB(B0, 1, 0); PG8_LDB(B1, 1, 1); PG8_SCHED; PG8_LDA(At, 1, 0); PG8_STAGE_A(PG8_SA(0, 1), a2, 1, va);
            PG8_WAIT_V(8); PG8_WAIT_L(0); PG8_BAR; PG8_MMA(0, 0, At, B0); PG8_MMA(0, 1, At, B1); PG8_BAR; PG8_SCHED;
            PG8_LDA(At, 1, 1); PG8_STAGE(PG8_SB(1, 0), b3, voffB); PG8_STAGE(PG8_SB(1, 1), b3 + hstep, voffB); PG8_STAGE_A(PG8_SA(1, 0), a3, 0, va);
            PG8_WAIT_V(8); PG8_WAIT_L(0); PG8_BAR; PG8_MMA(1, 0, At, B0); PG8_MMA(1, 1, At, B1); PG8_BAR; PG8_SCHED;
        }
        if (wr == 0) PG8_BAR;
        E(acc, cur, wr, wc, fr, fq);
        if (!has_next) break;
#pragma unroll
        for (int a = 0; a < 2; ++a)
#pragma unroll
            for (int b = 0; b < 2; ++b)
#pragma unroll
                for (int m = 0; m < 4; ++m)
#pragma unroll
                    for (int n = 0; n < 2; ++n) acc[a][b][m][n] = (f32x4){0.f, 0.f, 0.f, 0.f};
        cur = nxt; cA = nA; cB = nB; ++ui;
        if (wr == 1) PG8_BAR;
    }
    PG8_WAIT_V(0);
    PG8_BAR;
#undef PG8_SA
#undef PG8_SB
#undef PG8_STAGE
#undef PG8_STAGE_A
#undef PG8_LDA
#undef PG8_LDB
#undef PG8_MMA
#undef PG8_WAIT_V
#undef PG8_WAIT_L
#undef PG8_BAR
#undef PG8_SCHED
#undef PG8_AOFF
}
}

struct Args { const float* in[20]; float* out; unsigned char* ws; int s_lo, s_hi; };
#define P_x (A.in[0])
#define P_c (A.in[1])
#define P_norm1_g (A.in[2])
#define P_w_mod (A.in[3])
#define P_b_mod (A.in[4])
#define P_w_in (A.in[5])
#define P_q_g (A.in[6])
#define P_k_g (A.in[7])
#define P_rel_bias (A.in[8])
#define P_pool_w (A.in[9])
#define P_pool_b (A.in[10])
#define P_pool_scale (A.in[11])
#define P_w_out (A.in[12])
#define P_norm2_g (A.in[13])
#define P_router_w (A.in[14])
#define P_router_b (A.in[15])
#define P_exp_w1 (A.in[16])
#define P_exp_b1 (A.in[17])
#define P_exp_w2 (A.in[18])
#define P_exp_b2 (A.in[19])
#define P_out (A.out)
#define P_PWT ((bf16*)(A.ws + WS_PWT))
#define P_mod ((float*)(A.ws + WS_MOD))
#define P_rwT ((float*)(A.ws + WS_RWT))
#define P_gate ((float*)(A.ws + WS_GATE))
#define P_slot ((int*)(A.ws + WS_SLOT))
#define P_tok ((int*)(A.ws + WS_TOK))
#define P_WIN ((bf16*)(A.ws + WS_WIN))
#define P_WOUT ((bf16*)(A.ws + WS_WOUT))
#define P_XN ((bf16*)(A.ws + WS_XN))
#define P_QKVU ((bf16*)(A.ws + WS_QKVU))
#define P_MIX ((bf16*)(A.ws + WS_MIX))
#define P_H ((bf16*)(A.ws + WS_H))
#define P_OB ((bf16*)(A.ws + WS_OB))
#define P_W1 ((bf16*)(A.ws + WS_W1))
#define P_W2 ((bf16*)(A.ws + WS_W2))
constexpr int NWAVES = 8;
struct Frame {
    LAS unsigned char* lds;
    volatile LAS unsigned* MISC;
    gu32* ctl;
    int tid, lane, wave, vcu, G;
};

__device__ __forceinline__ void p0_mod(Frame& F, const Args& A) {
    LAS float* cond = (LAS float*)(F.lds);
    LAS float* red = (LAS float*)(F.lds + 16384);
    for (int i = F.tid; i < NB * D; i += NWAVES * 64) { const float cv = P_c[i]; cond[i] = cv / (1.f + __expf(-cv)); }
    __syncthreads();
    const int c4 = F.lane & 31, rs = F.lane >> 5;
    for (int it = F.vcu; it < DEPTH * (MODW / 128); it += F.G) {
        const int l = it / (MODW / 128), cb = it % (MODW / 128);
        f32x4 acc[4];
#pragma unroll
        for (int b = 0; b < 4; ++b) acc[b] = (f32x4){0.f, 0.f, 0.f, 0.f};
        const float* wp = P_w_mod + ((size_t)l * D + 128 * F.wave + rs) * MODW + 128 * cb + 4 * c4;
#pragma unroll 8
        for (int kk = 0; kk < 64; ++kk) {
            const f32x4 wv = *(const f32x4*)(wp + (size_t)(2 * kk) * MODW);
            const int k = 128 * F.wave + 2 * kk + rs;
#pragma unroll
            for (int b = 0; b < 4; ++b) acc[b] += cond[b * D + k] * wv;
        }
#pragma unroll
        for (int b = 0; b < 4; ++b)
#pragma unroll
            for (int i = 0; i < 4; ++i) acc[b][i] += __shfl_xor(acc[b][i], 32);
        if (rs == 0) {
#pragma unroll
            for (int b = 0; b < 4; ++b) *(LAS f32x4*)(red + (F.wave * 4 + b) * 128 + 4 * c4) = acc[b];
        }
        __syncthreads();
        { const int b = F.tid >> 7, col = F.tid & 127; float s = 0.f;
#pragma unroll
          for (int w = 0; w < 8; ++w) s += red[(w * 4 + b) * 128 + col];
          P_mod[((size_t)l * NB + b) * MODW + 128 * cb + col] = s + P_b_mod[(size_t)l * MODW + 128 * cb + col]; }
        __syncthreads();
    }
    __syncthreads();
}
__device__ __forceinline__ void tr_item(const float* W, int N, bf16* WT, int k0, int n0, int drow, LAS float* scr, int lane, int pitch = 1024) {
#pragma unroll 8
    for (int i = 0; i < 32; ++i) { const int kk = 2 * i + (lane >> 5); scr[kk * 33 + (lane & 31)] = W[(size_t)(k0 + kk) * N + n0 + (lane & 31)]; }
    LDS_WAIT(); asm volatile("" ::: "memory");
    const int c = lane & 7;
#pragma unroll
    for (int j = 0; j < 4; ++j) { const int n = (lane >> 3) + 8 * j; const LAS float* s = scr + (8 * c) * 33 + n;
        u32x4 o; o.x = pk2(s[0 * 33], s[1 * 33]); o.y = pk2(s[2 * 33], s[3 * 33]); o.z = pk2(s[4 * 33], s[5 * 33]); o.w = pk2(s[6 * 33], s[7 * 33]);
        *(GAS u32x4*)(WT + (size_t)(drow + n) * pitch + k0 + 8 * c) = o; }
    LDS_WAIT(); asm volatile("" ::: "memory");
}
__device__ __forceinline__ void p0_convert(Frame& F, const Args& A) {
    LAS float* scr = (LAS float*)(F.lds + RING_OFF + F.wave * 16384);
    const int gw = F.vcu * NWAVES + F.wave, NGW = F.G * NWAVES;
    constexpr int I_IN = DEPTH * 16 * 64, I_OUT = DEPTH * 16 * 32, I_W1 = DEPTH * NE * 16 * 64, I_W2 = DEPTH * NE * 16 * 32;
    for (int it = gw; it < I_IN + I_OUT + I_W1 + I_W2; it += NGW) {
        int r = it;
        if (r < I_IN) { const int l = r >> 10, rr = r & 1023, kb = rr >> 6, nb = rr & 63, n0 = 32 * nb, g = (n0 & 255) >> 5;
            tr_item(P_w_in + (size_t)l * D * INW, INW, P_WIN + (size_t)l * INW * D, 64 * kb, n0, (n0 & ~255) + 128 * (g & 1) + 32 * (g >> 1), scr, F.lane); continue; }
        r -= I_IN;
        if (r < I_OUT) { const int l = r >> 9, rr = r & 511, kb = rr >> 5, nb = rr & 31;
            tr_item(P_w_out + (size_t)l * D * D, D, P_WOUT + (size_t)l * D * D, 64 * kb, 32 * nb, 32 * nb, scr, F.lane); continue; }
        r -= I_OUT;
        if (r < I_W1) { const int le = r >> 10, rr = r & 1023, kb = rr >> 6, nb = rr & 63, n0 = 32 * nb, bj = n0 >> 10, jj = n0 & 1023;
            tr_item(P_exp_w1 + (size_t)le * D * 2048, 2048, P_W1 + (size_t)le * 2048 * D, 64 * kb, n0, 256 * (jj >> 7) + 128 * bj + (jj & 127), scr, F.lane); continue; }
        r -= I_W1;
        { const int le = r >> 9, rr = r & 511, kb = rr >> 5, nb = rr & 31;
            tr_item(P_exp_w2 + (size_t)le * FE * D, D, P_W2 + (size_t)le * D * FE, 64 * kb, 32 * nb, 32 * nb, scr, F.lane); }
    }
    for (int it = gw; it < DEPTH * 4 * 8; it += NGW) { const int m = it >> 3, rr = it & 7, kb = rr >> 2, nb = rr & 3;
        tr_item(P_pool_w + (size_t)m * PGRP * PGRP, PGRP, P_PWT + (size_t)m * PGRP * PGRP, 64 * kb, 32 * nb, 32 * nb, scr, F.lane, PGRP); }
    for (int i = (F.vcu * NWAVES * 64 + F.tid); i < DEPTH * NE * D; i += F.G * NWAVES * 64) { const int l = i >> 15, e = (i >> 10) & 31, cc = i & 1023; P_rwT[i] = P_router_w[((size_t)l * D + cc) * NE + e]; }
}

__device__ __forceinline__ int moe_tables(Frame& F, int l) {
    LAS int* X = (LAS int*)(F.lds + XTR_OFF);
    __syncthreads();
    if (F.tid < NE) X[F.tid] = (int)__hip_atomic_load(F.ctl + CW_CNT + 64 * l + F.tid, RLX_AGENT);
    __syncthreads();
    if (F.tid == 0) { int t = 0; for (int e = 0; e < NE; ++e) { X[32 + e] = t; t += (X[e] + 255) >> 8; } X[32 + NE] = t; X[66] = t; }
    __syncthreads();
    if (F.tid < NE) { const int t0 = X[32 + F.tid], t1 = X[33 + F.tid]; for (int t = t0; t < t1; ++t) X[128 + t] = F.tid; }
    __syncthreads();
    return X[66];
}

template <bool COMBINE, bool NORM>
__device__ __forceinline__ void phase_cn(Frame& F, const Args& A, int l) {
    LAS int* X = (LAS int*)(F.lds + XTR_OFF);
    if (COMBINE) (void)moe_tables(F, l - 1);
    const float* xin = (COMBINE || l > 0) ? P_out : P_x;
    for (int rb = F.vcu * NWAVES + F.wave; rb < M / 8; rb += F.G * NWAVES) {
        const int row0 = rb * 8, b = row0 / SEQ;
        f32x4 a[4], s[4], g2v[4];
#pragma unroll
        for (int j = 0; j < 4; ++j) {
            const int c = 4 * F.lane + 256 * j;
            if (NORM) { const f32x4 g = *(const f32x4*)(P_norm1_g + (size_t)l * D + c); const float* mp = P_mod + ((size_t)l * NB + b) * MODW;
                a[j] = g * (*(const f32x4*)(mp + D + c) + 1.0f); s[j] = *(const f32x4*)(mp + c); }
            if (COMBINE) g2v[j] = *(const f32x4*)(P_mod + ((size_t)(l - 1) * NB + b) * MODW + 5 * D + c);
        }
        for (int r = 0; r < 8; ++r) {
            const int row = row0 + r;
            f32x4 xv[4];
#pragma unroll
            for (int j = 0; j < 4; ++j) xv[j] = *(const f32x4*)(xin + (size_t)row * D + 4 * F.lane + 256 * j);
            if (COMBINE) {
                f32x4 y[4];
#pragma unroll
                for (int j = 0; j < 4; ++j) y[j] = (f32x4){0.f, 0.f, 0.f, 0.f};
#pragma unroll
                for (int k = 0; k < TOPK; ++k) {
                    const int so = P_slot[row * 4 + k]; const float gt = P_gate[row * 4 + k];
                    const int e = so >> 14, pos = so & 16383; const size_t orow = (size_t)X[32 + e] * 256 + pos;
#pragma unroll
                    for (int j = 0; j < 4; ++j) { const u32x2 w = *(const u32x2*)(P_OB + orow * D + 4 * F.lane + 256 * j);
                        y[j] += gt * (f32x4){bflo(w.x), bfhi(w.x), bflo(w.y), bfhi(w.y)}; }
                }
#pragma unroll
                for (int j = 0; j < 4; ++j) { xv[j] += g2v[j] * y[j]; *(f32x4*)(P_out + (size_t)row * D + 4 * F.lane + 256 * j) = xv[j]; }
            }
            if (NORM) {
                float ss = 0.f;
#pragma unroll
                for (int j = 0; j < 4; ++j) ss += (xv[j][0] * xv[j][0] + xv[j][1] * xv[j][1]) + (xv[j][2] * xv[j][2] + xv[j][3] * xv[j][3]);
                const float rstd = __builtin_amdgcn_rsqf(wave_sum(ss) * (1.f / D) + EPS);
#pragma unroll
                for (int j = 0; j < 4; ++j) { const f32x4 h = xv[j] * rstd * a[j] + s[j]; u32x2 w; w.x = pk2(h[0], h[1]); w.y = pk2(h[2], h[3]);
                    *(u32x2*)(P_XN + (size_t)row * D + 4 * F.lane + 256 * j) = w; }
            }
        }
    }
}

__device__ __forceinline__ void argmax_wave(float& v, int& e) {
#pragma unroll
    for (int o = 32; o >= 1; o >>= 1) { const float ov = __shfl_xor(v, o); const int oe = __shfl_xor(e, o); if (ov > v || (ov == v && oe < e)) { v = ov; e = oe; } }
}
__device__ __forceinline__ void phase_router(Frame& F, const Args& A, int l) {
    LAS f32x4* rw = (LAS f32x4*)F.lds;
    LAS int* X = (LAS int*)(F.lds + XTR_OFF);
    { const f32x4* src = (const f32x4*)(P_rwT + (size_t)l * NE * D); for (int i = F.tid; i < NE * D / 4; i += NWAVES * 64) rw[i] = src[i]; }
    if (F.tid < NE) X[F.tid] = 0;
    __syncthreads();
    for (int rb = F.vcu; rb < M / 64; rb += F.G) {
        const int row0 = rb * 64 + F.wave * 8, b = row0 / SEQ;
        f32x4 a[4], s[4];
#pragma unroll
        for (int j = 0; j < 4; ++j) { const int c = 4 * F.lane + 256 * j; const f32x4 g = *(const f32x4*)(P_norm2_g + (size_t)l * D + c); const float* mp = P_mod + ((size_t)l * NB + b) * MODW;
            a[j] = g * (*(const f32x4*)(mp + 4 * D + c) + 1.0f); s[j] = *(const f32x4*)(mp + 3 * D + c); }
        for (int pr = 0; pr < 4; ++pr) {
            f32x4 h[2][4];
#pragma unroll
            for (int r = 0; r < 2; ++r) {
                const int row = row0 + 2 * pr + r;
                float ss = 0.f;
#pragma unroll
                for (int j = 0; j < 4; ++j) { h[r][j] = *(const f32x4*)(P_out + (size_t)row * D + 4 * F.lane + 256 * j); ss += (h[r][j][0] * h[r][j][0] + h[r][j][1] * h[r][j][1]) + (h[r][j][2] * h[r][j][2] + h[r][j][3] * h[r][j][3]); }
                const float rstd = __builtin_amdgcn_rsqf(wave_sum(ss) * (1.f / D) + EPS);
#pragma unroll
                for (int j = 0; j < 4; ++j) { h[r][j] = h[r][j] * rstd * a[j] + s[j]; u32x2 w; w.x = pk2(h[r][j][0], h[r][j][1]); w.y = pk2(h[r][j][2], h[r][j][3]);
                    *(u32x2*)(P_XN + (size_t)row * D + 4 * F.lane + 256 * j) = w; }
            }
            float t16[2][16];
            { const bool up32 = (F.lane & 32) != 0;
#pragma unroll
              for (int i = 0; i < 16; ++i) {
                float pl0 = 0.f, pl1 = 0.f, ph0 = 0.f, ph1 = 0.f;
#pragma unroll
                for (int j = 0; j < 4; ++j) { const f32x4 wl = rw[i * 256 + 64 * j + F.lane], wh = rw[(i + 16) * 256 + 64 * j + F.lane];
                    pl0 += (h[0][j][0] * wl[0] + h[0][j][1] * wl[1]) + (h[0][j][2] * wl[2] + h[0][j][3] * wl[3]);
                    pl1 += (h[1][j][0] * wl[0] + h[1][j][1] * wl[1]) + (h[1][j][2] * wl[2] + h[1][j][3] * wl[3]);
                    ph0 += (h[0][j][0] * wh[0] + h[0][j][1] * wh[1]) + (h[0][j][2] * wh[2] + h[0][j][3] * wh[3]);
                    ph1 += (h[1][j][0] * wh[0] + h[1][j][1] * wh[1]) + (h[1][j][2] * wh[2] + h[1][j][3] * wh[3]); }
                t16[0][i] = (up32 ? ph0 : pl0) + __shfl_xor(up32 ? pl0 : ph0, 32);
                t16[1][i] = (up32 ? ph1 : pl1) + __shfl_xor(up32 ? pl1 : ph1, 32);
                asm volatile("" ::: "memory"); __builtin_amdgcn_sched_barrier(0);
              } }
#pragma unroll
            for (int r = 0; r < 2; ++r) {
                float t8[8], t4[4], t2[2];
                { const bool up = (F.lane & 16) != 0;
#pragma unroll
                  for (int i = 0; i < 8; ++i) { const float lo = t16[r][i], hi = t16[r][i + 8]; t8[i] = (up ? hi : lo) + __shfl_xor(up ? lo : hi, 16); } }
                { const bool up = (F.lane & 8) != 0;
#pragma unroll
                  for (int i = 0; i < 4; ++i) { const float lo = t8[i], hi = t8[i + 4]; t4[i] = (up ? hi : lo) + __shfl_xor(up ? lo : hi, 8); } }
                { const bool up = (F.lane & 4) != 0;
#pragma unroll
                  for (int i = 0; i < 2; ++i) { const float lo = t4[i], hi = t4[i + 2]; t2[i] = (up ? hi : lo) + __shfl_xor(up ? lo : hi, 4); } }
                float v;
                { const bool up = (F.lane & 2) != 0; const float lo = t2[0], hi = t2[1]; v = (up ? hi : lo) + __shfl_xor(up ? lo : hi, 2); }
                v += __shfl_xor(v, 1);
                const int me = F.lane >> 1;
                v += P_router_b[l * NE + me];
                float tv[4]; int te[4]; float cv = v;
#pragma unroll
                for (int k = 0; k < 4; ++k) { float bv = cv; int be = me; argmax_wave(bv, be); tv[k] = bv; te[k] = be; if (me == be) cv = -3.0e38f; }
                const float e1 = __expf(tv[1] - tv[0]), e2 = __expf(tv[2] - tv[0]), e3 = __expf(tv[3] - tv[0]); const float inv = 1.0f / (1.0f + e1 + e2 + e3);
                if (F.lane < 4) {
                    const int my_e = F.lane == 0 ? te[0] : F.lane == 1 ? te[1] : F.lane == 2 ? te[2] : te[3];
                    const float my_g = (F.lane == 0 ? 1.0f : F.lane == 1 ? e1 : F.lane == 2 ? e2 : e3) * inv;
                    const int lr = __hip_atomic_fetch_add(&X[my_e], 1, __ATOMIC_RELAXED, __HIP_MEMORY_SCOPE_WORKGROUP);
                    const int rl = F.wave * 8 + 2 * pr + r;
                    X[64 + rl * 4 + F.lane] = my_e | (lr << 8);
                    P_gate[(size_t)(rb * 64 + rl) * 4 + F.lane] = my_g;
                }
            }
        }
        __syncthreads();
        if (F.tid < NE) X[32 + F.tid] = (int)__hip_atomic_fetch_add(F.ctl + CW_CNT + 64 * l + F.tid, (unsigned)X[F.tid], RLX_AGENT);
        __syncthreads();
        if (F.tid < 256) { const int rl = F.tid >> 2, sv = X[64 + F.tid], e = sv & 255, lr = sv >> 8, pos = X[32 + e] + lr, row = rb * 64 + rl;
            P_tok[e * M + pos] = row; P_slot[row * 4 + (F.tid & 3)] = (e << 14) | pos; }
        __syncthreads();
        if (F.tid < NE) X[F.tid] = 0;
        __syncthreads();
    }
}


typedef float f32x16 __attribute__((ext_vector_type(16)));
typedef short s16x4 __attribute__((ext_vector_type(4)));
__device__ __forceinline__ s16x4 lds_tr16(LAS unsigned char* p) { return __builtin_bit_cast(s16x4, __builtin_amdgcn_ds_read_tr16_b64_v4i16((LAS s16x4*)p)); }
#define ATT_GLDS(gp, lp) __builtin_amdgcn_global_load_lds((const unsigned*)(gp), (LAS unsigned*)(lp), 16, 0, 0)
__device__ __forceinline__ void phase_attn(Frame& F, const Args& A, int l) {
    LAS unsigned char* wl = F.lds + F.wave * 16384;
    LAS float* bt = (LAS float*)(F.lds + XTR_OFF) + F.wave * 320;
    const int lane = F.lane, r = lane & 31, hh = lane >> 5;
    __syncthreads();
    unsigned koff[4], voff[4];
#pragma unroll
    for (int i = 0; i < 4; ++i) { const int row = 8 * i + (lane >> 3), cp = lane & 7, ck = cp ^ ((row >> 1) & 7), cv = cp ^ (4 * ((row >> 1) & 1));
        koff[i] = (unsigned)(row * INW * 2 + ck * 16); voff[i] = (unsigned)(row * INW * 2 + AW * 2 + cv * 16); }
    unsigned kaddr[4];
#pragma unroll
    for (int d0 = 0; d0 < 4; ++d0) { const int c = 2 * d0 + hh, cp = c ^ ((r >> 1) & 7); kaddr[d0] = (unsigned)(r * 128 + cp * 16); }
    unsigned vaddr[2];
    { const int li = lane & 15, q4 = li >> 2, p4 = li & 3, g = (lane >> 4) & 1;
#pragma unroll
      for (int db = 0; db < 2; ++db) { const int cp = 4 * (db ^ (q4 >> 1)) + 2 * g + (p4 >> 1); vaddr[db] = (unsigned)(4096 + (4 * hh + q4) * 128 + cp * 16 + 8 * (p4 & 1)); } }
    for (int uw = F.vcu * NWAVES + F.wave; uw < NB * NH * NCH; uw += F.G * NWAVES) {
        const int bh = uw >> 6, n = uw & 63, b = bh >> 3, h = bh & 7;
        { float v[5]; float mb = -3.0e38f;
#pragma unroll
          for (int i = 0; i < 5; ++i) { const int idx = lane + 64 * i; v[i] = idx < 257 ? P_rel_bias[((size_t)l * NH + h) * 257 + idx] * LOG2E : -3.0e38f; mb = fmaxf(mb, v[i]); }
#pragma unroll
          for (int o = 1; o < 64; o <<= 1) mb = fmaxf(mb, __shfl_xor(mb, o));
#pragma unroll
          for (int i = 0; i < 5; ++i) { const int idx = lane + 64 * i; if (idx < 257) bt[idx] = v[i] - mb; } }
        LDS_WAIT(); asm volatile("" ::: "memory");
        const int jlo = n >= LEFTC ? n - LEFTC : 0, NT = 2 * (n - jlo + 1);
        const char* kb0 = (const char*)(P_QKVU + (size_t)(b * SEQ + CHUNK * jlo) * INW + AW + h * HD);
#define ATT_ISSUE(t) do { const char* kb_ = kb0 + (size_t)(t) * 32 * INW * 2; LAS unsigned char* lb_ = wl + ((t) & 1) * 8192; \
        _Pragma("unroll") for (int i_ = 0; i_ < 4; ++i_) ATT_GLDS(kb_ + koff[i_], lb_ + i_ * 1024); \
        _Pragma("unroll") for (int i_ = 0; i_ < 4; ++i_) ATT_GLDS(kb_ + voff[i_], lb_ + 4096 + i_ * 1024); } while (0)
        ATT_ISSUE(0);
        bf16x8 qf[2][4];
        { const bf16* qp = P_QKVU + (size_t)(b * SEQ + CHUNK * n + r) * INW + h * HD + 8 * hh;
#pragma unroll
          for (int qb = 0; qb < 2; ++qb)
#pragma unroll
            for (int d0 = 0; d0 < 4; ++d0) qf[qb][d0] = *(const bf16x8*)(qp + (size_t)qb * 32 * INW + 16 * d0); }
        f32x16 o[2][2]; float lsum[2] = {0.f, 0.f};
#pragma unroll
        for (int qb = 0; qb < 2; ++qb)
#pragma unroll
            for (int db = 0; db < 2; ++db)
#pragma unroll
                for (int i = 0; i < 16; ++i) o[qb][db][i] = 0.f;
#pragma unroll 1
        for (int t = 0; t < NT; ++t) {
            if (t + 1 < NT) { ATT_ISSUE(t + 1); asm volatile("s_waitcnt vmcnt(8)" ::: "memory"); } else { asm volatile("s_waitcnt vmcnt(0)" ::: "memory"); }
            LAS unsigned char* tb = wl + (t & 1) * 8192;
            bf16x8 kf[4];
#pragma unroll
            for (int d0 = 0; d0 < 4; ++d0) kf[d0] = *(const LAS bf16x8*)(tb + kaddr[d0]);
            const int jj = jlo + (t >> 1) - (n - LEFTC), th = t & 1;
            bf16x8 pf[2][2];
#pragma unroll
            for (int qb = 0; qb < 2; ++qb) {
                f32x16 s;
                if (jj <= 5) { const float c0 = bt[0];
#pragma unroll
                    for (int i = 0; i < 16; ++i) s[i] = c0;
                } else {
                    const int relb = (jj - LEFTC) * CHUNK + 32 * th + 4 * hh - 32 * qb - r;
#pragma unroll
                    for (int i = 0; i < 16; ++i) { int rel = relb + (i & 3) + 8 * (i >> 2); rel = rel < -128 ? -128 : (rel > 128 ? 128 : rel); s[i] = bt[rel + 128]; }
                }
#pragma unroll
                for (int d0 = 0; d0 < 4; ++d0) s = __builtin_amdgcn_mfma_f32_32x32x16_bf16(kf[d0], qf[qb][d0], s, 0, 0, 0);
                float ls = 0.f;
#pragma unroll
                for (int i = 0; i < 16; ++i) { s[i] = __builtin_amdgcn_exp2f(s[i]); ls += s[i]; }
                lsum[qb] += ls;
#pragma unroll
                for (int st = 0; st < 2; ++st) { u32x4 w; w.x = cvt_pk_bf16(s[8 * st + 0], s[8 * st + 1]); w.y = cvt_pk_bf16(s[8 * st + 2], s[8 * st + 3]); w.z = cvt_pk_bf16(s[8 * st + 4], s[8 * st + 5]); w.w = cvt_pk_bf16(s[8 * st + 6], s[8 * st + 7]);
                    pf[qb][st] = __builtin_bit_cast(bf16x8, w); }
            }
#pragma unroll
            for (int db = 0; db < 2; ++db)
#pragma unroll
                for (int st = 0; st < 2; ++st) {
                    const s16x4 lo = lds_tr16(tb + vaddr[db] + st * 2048), hi = lds_tr16(tb + vaddr[db] + st * 2048 + 1024);
                    const bf16x8 vf = (bf16x8){lo[0], lo[1], lo[2], lo[3], hi[0], hi[1], hi[2], hi[3]};
#pragma unroll
                    for (int qb = 0; qb < 2; ++qb) o[qb][db] = __builtin_amdgcn_mfma_f32_32x32x16_bf16(vf, pf[qb][st], o[qb][db], 0, 0, 0);
                }
            LDS_WAIT(); asm volatile("" ::: "memory");
        }
#undef ATT_ISSUE
#pragma unroll
        for (int qb = 0; qb < 2; ++qb) {
            const float lt = lsum[qb] + __shfl_xor(lsum[qb], 32); const float il = 1.0f / lt;
            bf16* op = P_MIX + (size_t)(b * SEQ + CHUNK * n + 32 * qb + r) * D + h * HD + 4 * hh;
#pragma unroll
            for (int db = 0; db < 2; ++db)
#pragma unroll
                for (int g4 = 0; g4 < 4; ++g4) { u32x2 w; w.x = cvt_pk_bf16(o[qb][db][4 * g4 + 0] * il, o[qb][db][4 * g4 + 1] * il); w.y = cvt_pk_bf16(o[qb][db][4 * g4 + 2] * il, o[qb][db][4 * g4 + 3] * il);
                    *(u32x2*)(op + 32 * db + 8 * g4) = w; }
        }
    }
    __syncthreads();
}
__device__ __forceinline__ void phase_pool(Frame& F, const Args& A, int l) {
    LAS unsigned char* wl = F.lds + F.wave * 16384;
    const int lane = F.lane, r = lane & 31, hh = lane >> 5;
    __syncthreads();
    for (int uw = F.vcu * NWAVES + F.wave; uw < (M / 32) * 4; uw += F.G * NWAVES) {
        const int g = uw & 3, rb = uw >> 2, w = 2 << g, row0 = rb * 32, t0 = row0 % SEQ;
        const bf16* up = P_QKVU + (size_t)row0 * INW + 3 * AW + g * PGRP + 2 * lane;
        float s0 = 0.f, s1 = 0.f;
        for (int k = 1; k < w; ++k) { if (t0 - k >= 0) { const unsigned v = *(const unsigned*)(up - (size_t)k * INW); s0 += bflo(v); s1 += bfhi(v); } }
#pragma unroll 4
        for (int i = 0; i < 32; ++i) {
            const unsigned v = *(const unsigned*)(up + (size_t)i * INW); const float u0 = bflo(v), u1 = bfhi(v);
            s0 += u0; s1 += u1;
            const int tp = t0 + i; const float ic = 1.0f / (float)((tp + 1) < w ? (tp + 1) : w);
            *(LAS unsigned*)(wl + i * 256 + 4 * lane) = pk2(s0 * ic - u0, s1 * ic - u1);
            if (tp - w + 1 >= 0) { const unsigned vo = *(const unsigned*)(up + (size_t)(i - w + 1) * INW); s0 -= bflo(vo); s1 -= bfhi(vo); }
        }
        LDS_WAIT(); asm volatile("" ::: "memory");
        bf16x8 df[8];
#pragma unroll
        for (int st = 0; st < 8; ++st) df[st] = *(const LAS bf16x8*)(wl + r * 256 + 32 * st + 16 * hh);
        const bf16* wt = P_PWT + ((size_t)(l * 4 + g) * PGRP + r) * PGRP + 8 * hh;
        const float* pb = P_pool_b + l * 512 + g * PGRP + 4 * hh; const float* ps = P_pool_scale + l * 512 + g * PGRP + 4 * hh;
        bf16* op = P_MIX + (size_t)(row0 + r) * D + AW + g * PGRP + 4 * hh;
#pragma unroll 1
        for (int jb = 0; jb < 4; ++jb) {
            f32x16 acc;
#pragma unroll
            for (int i = 0; i < 16; ++i) acc[i] = 0.f;
#pragma unroll
            for (int st = 0; st < 8; ++st) { const bf16x8 wf = *(const bf16x8*)(wt + (size_t)jb * 32 * PGRP + 16 * st); acc = __builtin_amdgcn_mfma_f32_32x32x16_bf16(wf, df[st], acc, 0, 0, 0); }
#pragma unroll
            for (int g4 = 0; g4 < 4; ++g4) { const f32x4 bv = *(const f32x4*)(pb + 32 * jb + 8 * g4), sv = *(const f32x4*)(ps + 32 * jb + 8 * g4);
                u32x2 wv; wv.x = cvt_pk_bf16((acc[4 * g4 + 0] + bv[0]) * sv[0], (acc[4 * g4 + 1] + bv[1]) * sv[1]); wv.y = cvt_pk_bf16((acc[4 * g4 + 2] + bv[2]) * sv[2], (acc[4 * g4 + 3] + bv[3]) * sv[3]);
                *(u32x2*)(op + 32 * jb + 8 * g4) = wv; }
        }
        LDS_WAIT(); asm volatile("" ::: "memory");
    }
    __syncthreads();
}

__device__ __forceinline__ void phase_attn_naive(Frame& F, const Args& A, int l) {
    LAS unsigned char* kt = F.lds + F.wave * 16384;
    LAS float* bt = (LAS float*)(F.lds + XTR_OFF) + F.wave * 320;
    const int h = F.wave;
    __syncthreads();
    for (int i = F.lane; i < 257; i += 64) bt[i] = P_rel_bias[((size_t)l * NH + h) * 257 + i] * LOG2E;
    LDS_WAIT();
    const int hf = F.lane >> 5, d0 = 32 * hf;
    for (int un = F.vcu; un < NB * NCH; un += F.G) {
        const int b = un / NCH, n = un % NCH;
#pragma unroll 1
        for (int pass = 0; pass < 2; ++pass) {
            const int qi = 32 * pass + (F.lane & 31); const int qrow = b * SEQ + n * CHUNK + qi;
            float q[32], o[32];
            { const u32x4* qp = (const u32x4*)(P_QKVU + (size_t)qrow * INW + h * HD + d0);
#pragma unroll
              for (int c = 0; c < 4; ++c) { const u32x4 w = qp[c]; q[8 * c + 0] = bflo(w.x); q[8 * c + 1] = bfhi(w.x); q[8 * c + 2] = bflo(w.y); q[8 * c + 3] = bfhi(w.y); q[8 * c + 4] = bflo(w.z); q[8 * c + 5] = bfhi(w.z); q[8 * c + 6] = bflo(w.w); q[8 * c + 7] = bfhi(w.w); } }
#pragma unroll
            for (int d = 0; d < 32; ++d) o[d] = 0.f;
            float mrun = -1.0e30f, lrun = 0.f;
#pragma unroll 1
            for (int jj = (n >= LEFTC ? 0 : LEFTC - n); jj <= LEFTC; ++jj) {
                const int krow = b * SEQ + (n - LEFTC + jj) * CHUNK + F.lane;
                { const u32x4* kp = (const u32x4*)(P_QKVU + (size_t)krow * INW + AW + h * HD); const u32x4* vp = (const u32x4*)(P_QKVU + (size_t)krow * INW + 2 * AW + h * HD);
#pragma unroll
                  for (int c = 0; c < 8; ++c) { *(LAS u32x4*)(kt + F.lane * 128 + 16 * c) = kp[c]; *(LAS u32x4*)(kt + 8192 + F.lane * 128 + 16 * c) = vp[c]; } }
                LDS_WAIT(); asm volatile("" ::: "memory");
#pragma unroll 1
                for (int key = 0; key < 64; ++key) {
                    float acc = 0.f;
#pragma unroll
                    for (int c = 0; c < 4; ++c) { const u32x4 w = *(const LAS u32x4*)(kt + key * 128 + 2 * d0 + 16 * c);
                        acc += q[8 * c + 0] * bflo(w.x) + q[8 * c + 1] * bfhi(w.x) + q[8 * c + 2] * bflo(w.y) + q[8 * c + 3] * bfhi(w.y) + q[8 * c + 4] * bflo(w.z) + q[8 * c + 5] * bfhi(w.z) + q[8 * c + 6] * bflo(w.w) + q[8 * c + 7] * bfhi(w.w); }
                    acc += __shfl_xor(acc, 32);
                    int rel = (jj - LEFTC) * CHUNK + key - qi; rel = rel < -128 ? -128 : (rel > 128 ? 128 : rel);
                    const float sc = acc + bt[rel + 128];
                    const float mnew = fmaxf(mrun, sc), alpha = __builtin_amdgcn_exp2f(mrun - mnew), p = __builtin_amdgcn_exp2f(sc - mnew);
                    mrun = mnew; lrun = lrun * alpha + p;
#pragma unroll
                    for (int c = 0; c < 4; ++c) { const u32x4 w = *(const LAS u32x4*)(kt + 8192 + key * 128 + 2 * d0 + 16 * c);
                        o[8 * c + 0] = o[8 * c + 0] * alpha + p * bflo(w.x); o[8 * c + 1] = o[8 * c + 1] * alpha + p * bfhi(w.x); o[8 * c + 2] = o[8 * c + 2] * alpha + p * bflo(w.y); o[8 * c + 3] = o[8 * c + 3] * alpha + p * bfhi(w.y);
                        o[8 * c + 4] = o[8 * c + 4] * alpha + p * bflo(w.z); o[8 * c + 5] = o[8 * c + 5] * alpha + p * bfhi(w.z); o[8 * c + 6] = o[8 * c + 6] * alpha + p * bflo(w.w); o[8 * c + 7] = o[8 * c + 7] * alpha + p * bfhi(w.w); }
                }
                LDS_WAIT(); asm volatile("" ::: "memory");
            }
            const float il = 1.0f / lrun;
            { u32x4* op = (u32x4*)(P_MIX + (size_t)qrow * D + h * HD + d0);
#pragma unroll
              for (int c = 0; c < 4; ++c) { u32x4 w; w.x = pk2(o[8 * c + 0] * il, o[8 * c + 1] * il); w.y = pk2(o[8 * c + 2] * il, o[8 * c + 3] * il); w.z = pk2(o[8 * c + 4] * il, o[8 * c + 5] * il); w.w = pk2(o[8 * c + 6] * il, o[8 * c + 7] * il); op[c] = w; } }
        }
    }
    __syncthreads();
}
__device__ __forceinline__ void phase_pool_naive(Frame& F, const Args& A, int l) {
    LAS float* dl = (LAS float*)F.lds;
    __syncthreads();
    for (int un = F.vcu; un < (M / 64) * 4; un += F.G) {
        const int rb = un >> 2, g = un & 3, w = 2 << g;
        { const int c = F.tid & 127, r0 = F.tid >> 7;
          for (int i = 0; i < 16; ++i) { const int r = r0 + 4 * i, row = rb * 64 + r, tpos = row % SEQ; const int cnt = (tpos + 1) < w ? (tpos + 1) : w;
              float sum = 0.f; for (int s = 0; s < cnt; ++s) sum += bflo((unsigned)P_QKVU[(size_t)(row - s) * INW + 3 * AW + g * PGRP + c]);
              const float ut = bflo((unsigned)P_QKVU[(size_t)row * INW + 3 * AW + g * PGRP + c]);
              dl[r * 129 + c] = sum / (float)cnt - ut; } }
        __syncthreads();
        { const int j = F.tid & 127, rq = F.tid >> 7; float acc[16];
#pragma unroll
          for (int i = 0; i < 16; ++i) acc[i] = 0.f;
          const float* pw = P_pool_w + ((size_t)(l * 4 + g) * PGRP) * PGRP + j;
          for (int c = 0; c < PGRP; ++c) { const float wv = pw[(size_t)c * PGRP];
#pragma unroll
              for (int i = 0; i < 16; ++i) acc[i] += dl[(rq + 4 * i) * 129 + c] * wv; }
          const float pb = P_pool_b[l * 512 + g * PGRP + j], ps = P_pool_scale[l * 512 + g * PGRP + j];
#pragma unroll
          for (int i = 0; i < 16; ++i) P_MIX[(size_t)(rb * 64 + rq + 4 * i) * D + AW + g * PGRP + j] = (bf16)f2bf((acc[i] + pb) * ps); }
        __syncthreads();
    }
}

constexpr int NSTEP = 1 + 7 * DEPTH + 1;

__global__ void __launch_bounds__(NWAVES * 64, 2) mk_fwd(Args args) {
    const Args& A = args;
    extern __shared__ __attribute__((aligned(16))) unsigned char lds[];
    Frame F;
    F.lds = (LAS unsigned char*)lds;
    F.MISC = (volatile LAS unsigned*)(F.lds + LDSCTL_OFF);
    F.tid = threadIdx.x; F.lane = F.tid & 63; F.wave = __builtin_amdgcn_readfirstlane(F.tid >> 6);
    F.G = gridDim.x; { const int bx = blockIdx.x; F.vcu = (F.G % 8 == 0) ? (bx % 8) * (F.G / 8) + bx / 8 : bx; }
    unsigned char* ws = args.ws;
    F.ctl = (gu32*)(ws + WS_CTL);
    for (int u = F.tid; u < 128; u += NWAVES * 64) ((LAS unsigned*)(F.lds + LDSCTL_OFF))[u] = 0u;
    __syncthreads();
    XcdBarrier bar; bar.bar = (unsigned*)(F.ctl + CW_BAR); bar.x = 0; bar.st = nullptr;
    const int lo = args.s_lo, hi = args.s_hi;
    if (hi - lo > 1) bar = xcd_barrier_post((unsigned*)(F.ctl + CW_BAR), F.MISC + 8);
#define IN(k) (lo <= (k) && (k) < hi)
#define OPAQUE() do { asm volatile("" : "+v"(F.tid)); F.lane = F.tid & 63; F.wave = __builtin_amdgcn_readfirstlane(F.tid >> 6); } while (0)
#define SEAM(k) do { if (IN(k) && IN((k) + 1)) xcd_barrier(bar); } while (0)

    if (IN(0)) { OPAQUE(); p0_mod(F, args); p0_convert(F, args); SEAM(0); }

    for (int l = 0; l < DEPTH; ++l) {
        const int sb = 1 + 7 * l;
        if (IN(sb + 0)) { OPAQUE(); if (l == 0) phase_cn<false, true>(F, args, l); else phase_cn<true, true>(F, args, l); SEAM(sb + 0); }
        if (IN(sb + 1)) { OPAQUE();
            pg8::DenseOrder S; S.init(M, INW, F.G, (int)blockIdx.x, P_XN, P_WIN + (size_t)l * INW * D);
            pg8::EpiWin E{P_QKVU, P_q_g + l * HD, P_k_g + l * HD};
            pg8::gemm_phase<pg8::EpiWin, pg8::DenseOrder, false>(F.lds + RING_OFF, S, E);
            SEAM(sb + 1);
        }
        if (IN(sb + 2)) {
#if ATTN_NAIVE
            OPAQUE(); phase_attn_naive(F, args, l);
#else
            OPAQUE(); phase_attn(F, args, l);
#endif
#if POOL_NAIVE
            OPAQUE(); phase_pool_naive(F, args, l);
#else
            OPAQUE(); phase_pool(F, args, l);
#endif
            SEAM(sb + 2); }
        if (IN(sb + 3)) { OPAQUE();
            pg8::DenseOrder S; S.init(M, D, F.G, (int)blockIdx.x, P_MIX, P_WOUT + (size_t)l * D * D);
            pg8::EpiWout E{l == 0 ? P_x : P_out, P_out, P_mod + (size_t)l * NB * MODW + 2 * D};
            pg8::gemm_phase<pg8::EpiWout, pg8::DenseOrder, false>(F.lds + RING_OFF, S, E);
            SEAM(sb + 3);
        }
        if (IN(sb + 4)) { OPAQUE(); phase_router(F, args, l); SEAM(sb + 4); }
        if (IN(sb + 5)) { OPAQUE();
            const int T = moe_tables(F, l);
            LAS int* X = (LAS int*)(F.lds + XTR_OFF);
            pg8::MoeOrder S; S.tile_e = X + 128; S.toff = (const LAS unsigned*)(X + 512); S.T = T; S.vcu = F.vcu; S.G = F.G; S.ncol = 8; S.rpb = 4;
            S.A = (const char*)P_XN; S.B = (const char*)(P_W1 + (size_t)l * NE * 2048 * D); S.estride = (size_t)2048 * D * 2; S.gather = true;
            { pg8::GUnit u; for (int i = 0; i < MAXU && S.next(i, u); ++i) { if (F.tid < 256) { const int e = u.e, base = u.row0 - X[32 + e] * 256 + F.tid, cnt = X[e]; const int idx = base < cnt ? base : cnt - 1;
                    ((LAS unsigned*)(X + 512))[i * 256 + F.tid] = (unsigned)P_tok[e * M + idx] * (unsigned)(D * 2); } } }
            __syncthreads();
            pg8::EpiSwiglu E{P_H, P_exp_b1 + (size_t)l * NE * 2048};
            pg8::gemm_phase<pg8::EpiSwiglu, pg8::MoeOrder, true>(F.lds + RING_OFF, S, E);
            SEAM(sb + 5);
        }
        if (IN(sb + 6)) { OPAQUE();
            const int T = moe_tables(F, l);
            LAS int* X = (LAS int*)(F.lds + XTR_OFF);
            pg8::MoeOrder S; S.tile_e = X + 128; S.toff = (const LAS unsigned*)(X + 512); S.T = T; S.vcu = F.vcu; S.G = F.G; S.ncol = 4; S.rpb = 8;
            S.A = (const char*)P_H; S.B = (const char*)(P_W2 + (size_t)l * NE * D * FE); S.estride = (size_t)D * FE * 2; S.gather = false;
            pg8::EpiOB E{P_OB, P_exp_b2 + (size_t)l * NE * D};
            pg8::gemm_phase<pg8::EpiOB, pg8::MoeOrder, false>(F.lds + RING_OFF, S, E);
            SEAM(sb + 6);
        }
    }
    if (IN(NSTEP - 1)) { OPAQUE(); phase_cn<true, false>(F, args, DEPTH); }
#undef IN
#undef OPAQUE
#undef SEAM
}

extern "C" void kernel_launch(void* const* d_in, const int* in_sizes, int n_in, void* d_out, int out_size, void* d_ws, size_t ws_size, hipStream_t stream) {
    static int grid = 0;
    if (grid == 0) {
        if (n_in != 20 || in_sizes[0] != M * D || out_size != M * D || ws_size < WS_END) { fprintf(stderr, "kernel_launch: unexpected shapes / workspace (n_in %d, ws %zu)\n", n_in, ws_size); grid = -1; return; }
        int dev = 0, cus = 0, per_cu = 0;
        if (hipGetDevice(&dev) != hipSuccess || hipDeviceGetAttribute(&cus, hipDeviceAttributeMultiprocessorCount, dev) != hipSuccess) { grid = -1; return; }
        if (hipFuncSetAttribute((const void*)mk_fwd, hipFuncAttributeMaxDynamicSharedMemorySize, LDS_BYTES) != hipSuccess) { fprintf(stderr, "kernel_launch: hipFuncSetAttribute failed\n"); grid = -1; return; }
        if (hipOccupancyMaxActiveBlocksPerMultiprocessor(&per_cu, (const void*)mk_fwd, NWAVES * 64, LDS_BYTES) != hipSuccess || per_cu < 1) fprintf(stderr, "kernel_launch: occupancy query reports %d\n", per_cu);
        (void)hipGetLastError();
        grid = cus;
    }
    if (grid < 0) return;
    if (hipMemsetAsync((char*)d_ws + WS_CTL, 0, CTL_ZERO_BYTES, stream) != hipSuccess) return;
    Args a{};
    for (int i = 0; i < 20; ++i) a.in[i] = (const float*)d_in[i];
    a.out = (float*)d_out; a.ws = (unsigned char*)d_ws;
#if MK_ONE_LAUNCH
    a.s_lo = 0; a.s_hi = NSTEP;
    hipLaunchKernelGGL(mk_fwd, dim3(grid), dim3(NWAVES * 64), LDS_BYTES, stream, a);
#else
    for (int s = 0; s < NSTEP; ++s) { a.s_lo = s; a.s_hi = s + 1; hipLaunchKernelGGL(mk_fwd, dim3(grid), dim3(NWAVES * 64), LDS_BYTES, stream, a); }
#endif
}
```

```cpp
#include <hip/hip_runtime.h>
#include <cstdio>
#include <cstdint>

#ifndef ATTN_NAIVE
#define ATTN_NAIVE 0
#endif
#ifndef POOL_NAIVE
#define POOL_NAIVE 0
#endif
#ifndef PROBE_STEP
#define PROBE_STEP -1
#endif
#ifndef PROBE_OPT
#define PROBE_OPT 0
#endif
#ifndef MOE_FP8
#define MOE_FP8 1
#endif
#ifndef MK_ONE_LAUNCH
#define MK_ONE_LAUNCH 1
#endif

#define GAS __attribute__((address_space(1)))
#define LAS __attribute__((address_space(3)))
typedef unsigned short bf16;
typedef unsigned u32x4 __attribute__((ext_vector_type(4)));
typedef unsigned u32x2 __attribute__((ext_vector_type(2)));
typedef float f32x4 __attribute__((ext_vector_type(4)));
typedef float f32x2 __attribute__((ext_vector_type(2)));
typedef short bf16x8 __attribute__((ext_vector_type(8)));
typedef GAS unsigned gu32;

constexpr int NB = 4, SEQ = 4096, D = 1024, M = NB * SEQ, DEPTH = 4;
constexpr int CHUNK = 64, NCH = SEQ / CHUNK, LEFTC = 8;
constexpr int NH = 8, HD = 64, AW = 512, PGRP = 128, INW = 2048;
constexpr int NE = 32, TOPK = 4, FE = 1024;
constexpr int MAXT = 288;
constexpr int MAXU = 9;
constexpr float EPS = 1e-6f;
constexpr float LOG2E = 1.4426950408889634f;
constexpr int MODW = 6 * D;

constexpr size_t MiB = 1u << 20;
constexpr size_t WS_CTL = 0, CTL_ZERO_BYTES = 1 * MiB;
constexpr size_t WS_MOD = 1 * MiB;
constexpr size_t WS_RWT = 2 * MiB;
constexpr size_t WS_GATE = 3 * MiB;
constexpr size_t WS_SLOT = 3 * MiB + 512 * 1024;
constexpr size_t WS_TOK = 4 * MiB;
constexpr size_t WS_PWT = 6 * MiB;
constexpr size_t WS_WIN = 8 * MiB;
constexpr size_t WS_WOUT = 24 * MiB;
constexpr size_t WS_XN = 32 * MiB;
constexpr size_t WS_QKVU = 64 * MiB;
constexpr size_t WS_MIX = 128 * MiB;
constexpr size_t WS_H = 160 * MiB;
constexpr size_t WS_OB = 304 * MiB;
constexpr size_t WS_W1 = 448 * MiB;
constexpr size_t WS_W2 = 960 * MiB;
constexpr size_t WS_XN8 = 1216 * MiB;
constexpr size_t WS_END = 1232 * MiB;
constexpr int CW_TMO = 0, CW_CODE = 1;
constexpr int CW_BAR = 4096, BAR_STRIDE = 4096;
constexpr int CW_CNT = 131072;

constexpr int RING_OFF = 0, RING_BYTES = 131072;
constexpr int LDSCTL_OFF = RING_BYTES;
constexpr int XTR_OFF = RING_BYTES + 512;
constexpr int LDS_BYTES = 147456;
constexpr int XTR_BYTES = LDS_BYTES - XTR_OFF;

#define RLX_AGENT __ATOMIC_RELAXED, __HIP_MEMORY_SCOPE_AGENT
#define LDS_WAIT() asm volatile("s_waitcnt lgkmcnt(0)" ::: "memory")
#define VM_WAIT() asm volatile("s_waitcnt vmcnt(0)" ::: "memory")
__device__ __forceinline__ unsigned f2bf(float f) { unsigned u = __builtin_bit_cast(unsigned, f); return (u + 0x7fffu + ((u >> 16) & 1u)) >> 16; }
__device__ __forceinline__ unsigned pk2(float lo, float hi) { return f2bf(lo) | (f2bf(hi) << 16); }
__device__ __forceinline__ unsigned cvt_pk_bf16(float lo, float hi) { unsigned r; asm volatile("v_cvt_pk_bf16_f32 %0, %1, %2" : "=v"(r) : "v"(lo), "v"(hi)); return r; }
__device__ __forceinline__ unsigned pk4_fp8(float a, float b, float c, float d) { int w = __builtin_amdgcn_cvt_pk_fp8_f32(a, b, 0, false); w = __builtin_amdgcn_cvt_pk_fp8_f32(c, d, w, true); return (unsigned)w; }
constexpr float FP8_ACT_SCALE = 4.0f, FP8_W_SCALE = 64.0f;
constexpr int FP8_ACT_E8M0 = 0x7d7d7d7d, FP8_W_E8M0 = 0x79797979;
__device__ __forceinline__ float bflo(unsigned u) { return __builtin_bit_cast(float, u << 16); }
__device__ __forceinline__ float bfhi(unsigned u) { return __builtin_bit_cast(float, u & 0xffff0000u); }
__device__ __forceinline__ float wave_sum(float v) {
#pragma unroll
    for (int o = 1; o < 64; o <<= 1) v += __shfl_xor(v, o);
    return v;
}

#define XB_TMO      128
#define XB_XCNT(j)  (256  + 64 * (j))
#define XB_XSUB(j)  (1280 + 64 * (j))
#define XB_XGEN(j)  (2304 + 64 * (j))
#define XB_TOP      3328
#define XB_TOPGEN   3392
#define XCD_BAR_WORDS 3456
#define XB_SPIN_CAP (1u << 18)
__device__ __forceinline__ unsigned xb_ld(unsigned* p)              { return __hip_atomic_load(p, __ATOMIC_RELAXED, __HIP_MEMORY_SCOPE_AGENT); }
__device__ __forceinline__ unsigned xb_add(unsigned* p, unsigned v) { return __hip_atomic_fetch_add(p, v, __ATOMIC_RELAXED, __HIP_MEMORY_SCOPE_AGENT); }
__device__ __forceinline__ unsigned xb_xcc_id() { return (unsigned)__builtin_amdgcn_s_getreg((3 << 11) | 20) & 0xFu; }
#define XB_SPIN(cond, bar) do { unsigned _sp = 0; while (cond) { __builtin_amdgcn_s_sleep(1); \
    if ((++_sp & 255u) == 0u) { if (xb_ld(&(bar)[XB_TMO])) break; if (_sp > XB_SPIN_CAP) { atomicAdd(&(bar)[XB_TMO], 1u); break; } } } } while (0)
struct XcdBarrier { unsigned* bar; unsigned x; volatile LAS unsigned* st; };
__device__ __forceinline__ XcdBarrier xcd_barrier_post(unsigned* bar, volatile LAS unsigned* st) {
    XcdBarrier b; b.bar = bar; b.x = xb_xcc_id(); b.st = st;
    if (threadIdx.x == 0) (void)xb_add(&bar[XB_XCNT(b.x)], 1u);
    return b;
}
__device__ __forceinline__ void xcd_barrier_complete(unsigned* bar, unsigned x, unsigned& nloc, unsigned& nx) {
    const unsigned G = gridDim.x * gridDim.y * gridDim.z;
    unsigned sum, cnt, mine, sp = 0u;
    for (;;) {
        sum = 0u; cnt = 0u; mine = 0u;
#pragma unroll
        for (unsigned j = 0; j < 16; ++j) { const unsigned c = xb_ld(&bar[XB_XCNT(j)]); sum += c; cnt += (c > 0u) ? 1u : 0u; mine = (j == x) ? c : mine; }
        if (sum == G) break;
        __builtin_amdgcn_s_sleep(1);
        if ((++sp & 255u) == 0u) { if (xb_ld(&bar[XB_TMO])) break; if (sp > XB_SPIN_CAP) { atomicAdd(&bar[XB_TMO], 1u); break; } }
    }
    nloc = mine > 0u ? mine : 1u; nx = cnt > 0u ? cnt : 1u;
}
__device__ __forceinline__ void xcd_barrier(const XcdBarrier& b) {
    asm volatile("s_waitcnt vmcnt(0)" ::: "memory");
    __syncthreads();
    if (threadIdx.x == 0) {
        unsigned* bar = b.bar;
        __builtin_amdgcn_s_waitcnt(0);
        unsigned nloc = b.st[0], nx = b.st[1];
        if (nloc == 0u) { xcd_barrier_complete(bar, b.x, nloc, nx); b.st[0] = nloc; b.st[1] = nx; }
        const unsigned old = xb_add(&bar[XB_XSUB(b.x)], 1u);
        const unsigned gen = old / nloc;
        if (old + 1u == (gen + 1u) * nloc) {
            __builtin_amdgcn_fence(__ATOMIC_RELEASE, "agent");
            asm volatile("s_waitcnt vmcnt(0)" ::: "memory");
            const unsigned og = xb_add(&bar[XB_TOP], 1u);
            const unsigned tg = og / nx;
            if (og + 1u == (tg + 1u) * nx) xb_add(&bar[XB_TOPGEN], 1u);
            else XB_SPIN(xb_ld(&bar[XB_TOPGEN]) == tg, bar);
            __builtin_amdgcn_fence(__ATOMIC_ACQUIRE, "agent");
            xb_add(&bar[XB_XGEN(b.x)], 1u);
            asm volatile("s_waitcnt vmcnt(0)" ::: "memory");
        } else {
            XB_SPIN(xb_ld(&bar[XB_XGEN(b.x)]) == gen, bar);
            __builtin_amdgcn_fence(__ATOMIC_ACQUIRE, "agent");
            asm volatile("s_waitcnt vmcnt(0)" ::: "memory");
        }
    }
    __syncthreads();
}

namespace pg8 {
constexpr int BM = 256, BK = 64, HALF = 128, HTB = HALF * BK * 2, STAGE_BYTES = 8 * HTB, NXCD = 8, WGM = 8, KD = 1024;
constexpr size_t KSTEP = (size_t)BK * 2, HSTEP = (size_t)HALF * KD * 2, TSTEP = 2 * HSTEP;
__host__ __device__ __forceinline__ int lds_byte(int r, int c) { const int st = (r >> 4) * 2 + (c >> 5), rr = r & 15, cc = c & 31, ob = rr * 64 + cc * 2; return st * 1024 + (ob ^ (((ob >> 9) & 1) << 5)); }
__host__ __device__ __forceinline__ void stage_rc(int b, int& R, int& C) { const int st = b / 1024, sb = b % 1024, swz = sb ^ (((sb >> 9) & 1) << 5); R = (st >> 1) * 16 + swz / 64; C = (st & 1) * 32 + (swz % 64) / 2; }
__host__ __device__ __forceinline__ int perm32(int rho) { const int n = rho >> 4, i = rho & 15; return 8 * (i >> 2) + 4 * n + (i & 3); }

struct GUnit { const char* A; const char* B; int row0; int pn; int e; int li; };

struct DenseOrder {
    int nM, nN, nwg, G, c; const char* A; const char* B;
    __device__ __forceinline__ void init(int M_, int N_, int G_, int c_, const void* A_, const void* B_) { nM = M_ / BM; nN = N_ / BM; nwg = nM * nN; G = G_; c = c_; A = (const char*)A_; B = (const char*)B_; }
    __device__ __forceinline__ bool next(int i, GUnit& u) const {
        const long L = (long)i * G + c; if (L >= nwg) return false;
        int wgid = (int)L; { const int q = nwg / NXCD, r = nwg % NXCD, xcd = wgid % NXCD, off = wgid / NXCD; wgid = (xcd < r ? xcd * (q + 1) : r * (q + 1) + (xcd - r) * q) + off; }
        const int nig = WGM * nN, gid = wgid / nig, fm = gid * WGM, gsz = (nM - fm) < WGM ? (nM - fm) : WGM;
        const int pm = fm + ((wgid % nig) % gsz), pn = (wgid % nig) / gsz;
        u.A = A; u.B = B + (size_t)pn * TSTEP; u.row0 = pm * BM; u.pn = pn; u.e = 0; u.li = i; return true;
    }
    __device__ __forceinline__ unsigned rowoff(const GUnit& u, int r) const { return (unsigned)(u.row0 + r) * (unsigned)(KD * 2); }
};
template <bool TOK, int EBY>
struct MoeOrder {
    const LAS int* tile_e; const LAS unsigned* toff;
    int T, vcu, G, ncol, rpb; const char* A; const char* B; size_t estride, tstep;
    __device__ __forceinline__ bool next(int i, GUnit& u) const {
        const int uu = vcu + i * G; if (uu >= T * ncol) return false;
        const int blk = uu >> 5, j = uu & 31; int tib = T - blk * rpb; tib = tib > rpb ? rpb : tib;
        const int tile = blk * rpb + j % tib, pn = j / tib;
        const int e = __builtin_amdgcn_readfirstlane(tile_e[tile]);
        u.row0 = tile * BM; u.pn = pn; u.e = e; u.li = i;
        u.A = A; u.B = B + (size_t)e * estride + (size_t)pn * tstep; return true;
    }
    __device__ __forceinline__ unsigned rowoff(const GUnit& u, int r) const { if constexpr (TOK) return toff[u.li * 256 + r]; else return (unsigned)(u.row0 + r) * (unsigned)(KD * EBY); }
};

typedef f32x4 Acc[2][2][4][2];
typedef int i32x4 __attribute__((ext_vector_type(4)));
typedef int i32x8 __attribute__((ext_vector_type(8)));

struct EpiWin {
    static constexpr bool PERM = true;
    bf16* O; const float* qg; const float* kg;
    __device__ __forceinline__ void operator()(const Acc& acc, const GUnit& u, int wr, int wc, int fr, int fq) const {
        asm volatile("" : "+v"(fr), "+v"(fq));
        const int kind = u.pn >> 1;
        const int col0 = u.pn * 256 + 64 * wc + 8 * fq;
        f32x4 gv[2][2];
#pragma unroll
        for (int bj = 0; bj < 2; ++bj)
#pragma unroll
            for (int n = 0; n < 2; ++n) {
                const int d = 32 * bj + 8 * fq + 4 * n;
                if (kind == 0) gv[bj][n] = *(const f32x4*)(qg + d) * (0.125f * LOG2E);
                else if (kind == 1) gv[bj][n] = *(const f32x4*)(kg + d);
                else gv[bj][n] = (f32x4){1.f, 1.f, 1.f, 1.f};
            }
#pragma unroll
        for (int ai = 0; ai < 2; ++ai)
#pragma unroll
            for (int m = 0; m < 4; ++m) {
                const int row = u.row0 + ai * HALF + wr * 64 + m * 16 + fr;
                float rstd = 1.f;
                if (kind < 2) {
                    float ss = 0.f;
#pragma unroll
                    for (int bj = 0; bj < 2; ++bj)
#pragma unroll
                        for (int n = 0; n < 2; ++n) { const f32x4 x = acc[ai][bj][m][n]; ss += (x[0] * x[0] + x[1] * x[1]) + (x[2] * x[2] + x[3] * x[3]); }
                    ss += __shfl_xor(ss, 16); ss += __shfl_xor(ss, 32);
                    rstd = __builtin_amdgcn_rsqf(ss * (1.f / 64.f) + EPS);
                }
                bf16* rowp = O + (size_t)row * INW + col0;
#pragma unroll
                for (int bj = 0; bj < 2; ++bj) {
                    const f32x4 v0 = acc[ai][bj][m][0] * rstd * gv[bj][0], v1 = acc[ai][bj][m][1] * rstd * gv[bj][1];
                    u32x4 w; w.x = cvt_pk_bf16(v0[0], v0[1]); w.y = cvt_pk_bf16(v0[2], v0[3]); w.z = cvt_pk_bf16(v1[0], v1[1]); w.w = cvt_pk_bf16(v1[2], v1[3]);
                    *(u32x4*)(rowp + 32 * bj) = w;
                }
            }
    }
};
struct EpiWout {
    static constexpr bool PERM = false;
    const float* xin; float* xout; const float* g1;
    __device__ __forceinline__ void operator()(const Acc& acc, const GUnit& u, int wr, int wc, int fr, int fq) const {
        asm volatile("" : "+v"(fr), "+v"(fq));
        const int b = u.row0 / SEQ; const int col0 = u.pn * BM + wc * 32 + 4 * fq;
        f32x4 gv[2][2];
#pragma unroll
        for (int bj = 0; bj < 2; ++bj)
#pragma unroll
            for (int n = 0; n < 2; ++n) gv[bj][n] = *(const f32x4*)(g1 + (size_t)b * MODW + col0 + bj * HALF + n * 16);
#pragma unroll
        for (int ai = 0; ai < 2; ++ai)
#pragma unroll
            for (int m = 0; m < 4; ++m) {
                const size_t off = (size_t)(u.row0 + ai * HALF + wr * 64 + m * 16 + fr) * D + col0;
#pragma unroll
                for (int bj = 0; bj < 2; ++bj)
#pragma unroll
                    for (int n = 0; n < 2; ++n) { const f32x4 xv = *(const f32x4*)(xin + off + bj * HALF + n * 16); *(f32x4*)(xout + off + bj * HALF + n * 16) = xv + gv[bj][n] * acc[ai][bj][m][n]; }
                if (m & 1) asm volatile("" ::: "memory");
            }
    }
};
struct EpiSwiglu {
    static constexpr bool PERM = true;
    bf16* H; const float* b1;
    __device__ __forceinline__ void operator()(const Acc& acc, const GUnit& u, int wr, int wc, int fr, int fq) const {
        asm volatile("" : "+v"(fr), "+v"(fq));
        const int j0 = u.pn * 128 + wc * 32 + 8 * fq; const float* be = b1 + (size_t)u.e * 2048 + j0;
        f32x4 bg[2], bl[2];
#pragma unroll
        for (int n = 0; n < 2; ++n) { bg[n] = *(const f32x4*)(be + 4 * n); bl[n] = *(const f32x4*)(be + 1024 + 4 * n); }
#pragma unroll
        for (int ai = 0; ai < 2; ++ai)
#pragma unroll
            for (int m = 0; m < 4; ++m) {
                bf16* rowp = H + (size_t)(u.row0 + ai * HALF + wr * 64 + m * 16 + fr) * FE + j0;
                float o[8];
#pragma unroll
                for (int n = 0; n < 2; ++n)
#pragma unroll
                    for (int i = 0; i < 4; ++i) {
                        float g = acc[ai][0][m][n][i] + bg[n][i], l = acc[ai][1][m][n][i] + bl[n][i];
                        g = fminf(g, 7.0f); l = fminf(fmaxf(l, -7.0f), 7.0f);
                        const float sg = __builtin_amdgcn_rcpf(1.0f + __builtin_amdgcn_exp2f(-1.702f * LOG2E * g));
                        o[4 * n + i] = g * sg * (l + 1.0f);
                    }
#if MOE_FP8
                u32x2 w; w.x = pk4_fp8(o[0] * FP8_ACT_SCALE, o[1] * FP8_ACT_SCALE, o[2] * FP8_ACT_SCALE, o[3] * FP8_ACT_SCALE); w.y = pk4_fp8(o[4] * FP8_ACT_SCALE, o[5] * FP8_ACT_SCALE, o[6] * FP8_ACT_SCALE, o[7] * FP8_ACT_SCALE);
                *(u32x2*)((unsigned char*)H + (size_t)(u.row0 + ai * HALF + wr * 64 + m * 16 + fr) * FE + j0) = w;
#else
                u32x4 w; w.x = cvt_pk_bf16(o[0], o[1]); w.y = cvt_pk_bf16(o[2], o[3]); w.z = cvt_pk_bf16(o[4], o[5]); w.w = cvt_pk_bf16(o[6], o[7]);
                *(u32x4*)rowp = w;
#endif
            }
    }
};
struct EpiOB {
    static constexpr bool PERM = true;
    bf16* O; const float* b2;
    __device__ __forceinline__ void operator()(const Acc& acc, const GUnit& u, int wr, int wc, int fr, int fq) const {
        asm volatile("" : "+v"(fr), "+v"(fq));
        const int col0 = u.pn * BM + wc * 32 + 8 * fq; const float* be = b2 + (size_t)u.e * D + col0;
        f32x4 bv[2][2];
#pragma unroll
        for (int bj = 0; bj < 2; ++bj)
#pragma unroll
            for (int n = 0; n < 2; ++n) bv[bj][n] = *(const f32x4*)(be + bj * HALF + 4 * n);
#pragma unroll
        for (int ai = 0; ai < 2; ++ai)
#pragma unroll
            for (int m = 0; m < 4; ++m) {
                bf16* rowp = O + (size_t)(u.row0 + ai * HALF + wr * 64 + m * 16 + fr) * D + col0;
#pragma unroll
                for (int bj = 0; bj < 2; ++bj) {
                    const f32x4 v0 = acc[ai][bj][m][0] + bv[bj][0], v1 = acc[ai][bj][m][1] + bv[bj][1];
                    u32x4 w; w.x = cvt_pk_bf16(v0[0], v0[1]); w.y = cvt_pk_bf16(v0[2], v0[3]); w.z = cvt_pk_bf16(v1[0], v1[1]); w.w = cvt_pk_bf16(v1[2], v1[3]);
                    *(u32x4*)(rowp + bj * HALF) = w;
                }
            }
    }
};

template <class Epi, class Sched, bool GATHER, int EB = 2  >
__device__ __forceinline__ void gemm_phase(LAS unsigned char* lds, const Sched& S, const Epi& E) {
    int tid_ = threadIdx.x; asm volatile("" : "+v"(tid_));
    const int tid = tid_, wid = __builtin_amdgcn_readfirstlane(tid >> 6), lane = tid & 63, wr = wid >> 2, wc = wid & 3, fr = lane & 15, fq = lane >> 4;
    constexpr int K = KD, KB = K * EB  , nt = KB / (BK * 2);
    unsigned voffA[2], voffB[2]; int RA[2]; unsigned CA[2];
#pragma unroll
    for (int i = 0; i < 2; ++i) { int R, C; stage_rc(tid * 16 + i * 8192, R, C); const int Rb = Epi::PERM ? ((R & ~31) + perm32(R & 31)) : R;
        voffA[i] = (unsigned)(R * KB + C * 2); voffB[i] = (unsigned)(Rb * KB + C * 2); RA[i] = R; CA[i] = (unsigned)C * 2u; }
    constexpr size_t kstep = KSTEP, hstep = (size_t)HALF * KB;
    const unsigned ldsw = (unsigned)wid * 1024u;
    const int aoff = lds_byte(wr * 64 + fr, fq * 8), boff = lds_byte(wc * 32 + fr, fq * 8);
#define PG8_SA(b, h) (((b) * 2 + (h)) * HTB)
#define PG8_SB(b, h) ((4 + (b) * 2 + (h)) * HTB)
#define PG8_STAGE(bufoff, gbase, voff) do { _Pragma("unroll") for (int _i = 0; _i < 2; ++_i) \
        __builtin_amdgcn_global_load_lds((const unsigned*)((const char*)(gbase) + (voff)[_i]), (LAS unsigned*)(lds + (bufoff) + ldsw + _i * 8192), 16, 0, 0); } while (0)
#define PG8_STAGE_A(bufoff, base, h, V) do { if constexpr (GATHER) { PG8_STAGE(bufoff, base, (V)[h]); } else { PG8_STAGE(bufoff, (base) + (h) * hstep, voffA); } } while (0)
#define PG8_LD32(p) __builtin_shufflevector(*(const LAS i32x4*)(p), *(const LAS i32x4*)((p) + 1024), 0, 1, 2, 3, 4, 5, 6, 7)
#define PG8_LDA(dst, b, h) do { _Pragma("unroll") for (int m = 0; m < 4; ++m) dst[m] = PG8_LD32(lds + PG8_SA(b, h) + aoff + m * 2048); } while (0)
#define PG8_LDB(dst, b, h) do { _Pragma("unroll") for (int n = 0; n < 2; ++n) dst[n] = PG8_LD32(lds + PG8_SB(b, h) + boff + n * 2048); } while (0)
#define PG8_MMA(ai, bj, At, Bt) do { __builtin_amdgcn_s_setprio(1); _Pragma("unroll") for (int m = 0; m < 4; ++m) _Pragma("unroll") for (int n = 0; n < 2; ++n) { \
        if constexpr (EB == 2) {   \
            acc[ai][bj][m][n] = __builtin_amdgcn_mfma_f32_16x16x32_bf16(__builtin_bit_cast(bf16x8, __builtin_shufflevector(Bt[n], Bt[n], 0, 1, 2, 3)), __builtin_bit_cast(bf16x8, __builtin_shufflevector(At[m], At[m], 0, 1, 2, 3)), acc[ai][bj][m][n], 0, 0, 0); \
            acc[ai][bj][m][n] = __builtin_amdgcn_mfma_f32_16x16x32_bf16(__builtin_bit_cast(bf16x8, __builtin_shufflevector(Bt[n], Bt[n], 4, 5, 6, 7)), __builtin_bit_cast(bf16x8, __builtin_shufflevector(At[m], At[m], 4, 5, 6, 7)), acc[ai][bj][m][n], 0, 0, 0); } \
        else {   \
            acc[ai][bj][m][n] = __builtin_amdgcn_mfma_scale_f32_16x16x128_f8f6f4(Bt[n], At[m], acc[ai][bj][m][n], 0, 0, 0, FP8_W_E8M0, 0, FP8_ACT_E8M0); } } \
        __builtin_amdgcn_s_setprio(0); } while (0)
#define PG8_WAIT_V(n) asm volatile("s_waitcnt vmcnt(" #n ")" ::: "memory")
#define PG8_WAIT_L(n) asm volatile("s_waitcnt lgkmcnt(" #n ")" ::: "memory")
#define PG8_BAR __builtin_amdgcn_s_barrier()
#define PG8_SCHED __builtin_amdgcn_sched_barrier(0)
#define PG8_AOFF(V, U) do { if constexpr (GATHER) { _Pragma("unroll") for (int _h = 0; _h < 2; ++_h) _Pragma("unroll") for (int _i = 0; _i < 2; ++_i) (V)[_h][_i] = S.rowoff((U), _h * HALF + RA[_i]) + CA[_i]; } } while (0)
    GUnit cur, nxt; int ui = 0;
    if (!S.next(0, cur)) return;
    Acc acc;
#pragma unroll
    for (int a = 0; a < 2; ++a)
#pragma unroll
        for (int b = 0; b < 2; ++b)
#pragma unroll
            for (int m = 0; m < 4; ++m)
#pragma unroll
                for (int n = 0; n < 2; ++n) acc[a][b][m][n] = (f32x4){0.f, 0.f, 0.f, 0.f};
    i32x8 At[4], B0[2], B1[2];
    unsigned va[2][2] = {{0u, 0u}, {0u, 0u}};
    const char* cA = cur.A; const char* cB = cur.B;
    PG8_AOFF(va, cur);
    PG8_STAGE(PG8_SB(0, 0), cB, voffB); PG8_STAGE(PG8_SB(0, 1), cB + hstep, voffB); PG8_STAGE_A(PG8_SA(0, 0), cA, 0, va); PG8_STAGE_A(PG8_SA(0, 1), cA, 1, va);
    if (wr == 1) PG8_BAR;
    PG8_WAIT_V(2); PG8_BAR;
    PG8_STAGE(PG8_SB(1, 0), cB + kstep, voffB); PG8_STAGE_A(PG8_SA(1, 0), cA + kstep, 0, va); PG8_STAGE(PG8_SB(1, 1), cB + hstep + kstep, voffB);
    PG8_WAIT_V(6); PG8_BAR;
    for (;;) {
        const bool has_next = S.next(ui + 1, nxt);
        const char* nA = has_next ? nxt.A : cA; const char* nB = has_next ? nxt.B : cB;
#pragma unroll 1
        for (int t = 0; t < nt; t += 2) {
            const bool last = (t == nt - 2);
            const char* a1 = cA + (size_t)(t + 1) * kstep;
            const char* a2 = last ? nA : cA + (size_t)(t + 2) * kstep; const char* b2 = last ? nB : cB + (size_t)(t + 2) * kstep;
            const char* a3 = a2 + kstep; const char* b3 = b2 + kstep;
            PG8_LDB(B0, 0, 0); PG8_LDB(B1, 0, 1); PG8_SCHED; PG8_LDA(At, 0, 0); PG8_STAGE_A(PG8_SA(1, 1), a1, 1, va);
            if constexpr (GATHER) { if (last && has_next) { PG8_AOFF(va, nxt); } }
            PG8_WAIT_V(8); PG8_WAIT_L(0); PG8_BAR; PG8_MMA(0, 0, At, B0); PG8_MMA(0, 1, At, B1); PG8_BAR; PG8_SCHED;
            PG8_LDA(At, 0, 1); PG8_STAGE(PG8_SB(0, 0), b2, voffB); PG8_STAGE(PG8_SB(0, 1), b2 + hstep, voffB); PG8_STAGE_A(PG8_SA(0, 0), a2, 0, va);
            PG8_WAIT_V(8); PG8_WAIT_L(0); PG8_BAR; PG8_MMA(1, 0, At, B0); PG8_MMA(1, 1, At, B1); PG8_BAR; PG8_SCHED;
            PG8_LDB(B0, 1, 0); PG8_LDB(B1, 1, 1); PG8_SCHED; PG8_LDA(At, 1, 0); PG8_STAGE_A(PG8_SA(0, 1), a2, 1, va);
            PG8_WAIT_V(8); PG8_WAIT_L(0); PG8_BAR; PG8_MMA(0, 0, At, B0); PG8_MMA(0, 1, At, B1); PG8_BAR; PG8_SCHED;
            PG8_LDA(At, 1, 1); PG8_STAGE(PG8_SB(1, 0), b3, voffB); PG8_STAGE(PG8_SB(1, 1), b3 + hstep, voffB); PG8_STAGE_A(PG8_SA(1, 0), a3, 0, va);
            PG8_WAIT_V(8); PG8_WAIT_L(0); PG8_BAR; PG8_MMA(1, 0, At, B0); PG8_MMA(1, 1, At, B1); PG8_BAR; PG8_SCHED;
        }
        if (wr == 0) PG8_BAR;
        E(acc, cur, wr, wc, fr, fq);
        if (!has_next) break;
#pragma unroll
        for (int a = 0; a < 2; ++a)
#pragma unroll
            for (int b = 0; b < 2; ++b)
#pragma unroll
                for (int m = 0; m < 4; ++m)
#pragma unroll
                    for (int n = 0; n < 2; ++n) acc[a][b][m][n] = (f32x4){0.f, 0.f, 0.f, 0.f};
        cur = nxt; cA = nA; cB = nB; ++ui;
        if (wr == 1) PG8_BAR;
    }
    PG8_WAIT_V(0);
    PG8_BAR;
#undef PG8_SA
#undef PG8_SB
#undef PG8_STAGE
#undef PG8_STAGE_A
#undef PG8_LDA
#undef PG8_LDB
#undef PG8_MMA
#undef PG8_WAIT_V
#undef PG8_WAIT_L
#undef PG8_BAR
#undef PG8_SCHED
#undef PG8_AOFF
}
}

struct Args { const float* in[20]; float* out; unsigned char* ws; int s_lo, s_hi, li, opt; };
#define P_x (A.in[0])
#define P_c (A.in[1])
#define P_norm1_g (A.in[2])
#define P_w_mod (A.in[3])
#define P_b_mod (A.in[4])
#define P_w_in (A.in[5])
#define P_q_g (A.in[6])
#define P_k_g (A.in[7])
#define P_rel_bias (A.in[8])
#define P_pool_w (A.in[9])
#define P_pool_b (A.in[10])
#define P_pool_scale (A.in[11])
#define P_w_out (A.in[12])
#define P_norm2_g (A.in[13])
#define P_router_w (A.in[14])
#define P_router_b (A.in[15])
#define P_exp_w1 (A.in[16])
#define P_exp_b1 (A.in[17])
#define P_exp_w2 (A.in[18])
#define P_exp_b2 (A.in[19])
#define P_out (A.out)
#define P_PWT ((bf16*)(A.ws + WS_PWT))
#define P_XN8 ((unsigned char*)(A.ws + WS_XN8))
#define P_H8 ((unsigned char*)(A.ws + WS_H))
#define P_W18 ((unsigned char*)(A.ws + WS_W1))
#define P_W28 ((unsigned char*)(A.ws + WS_W2))
#define P_mod ((float*)(A.ws + WS_MOD))
#define P_rwT ((float*)(A.ws + WS_RWT))
#define P_gate ((float*)(A.ws + WS_GATE))
#define P_slot ((int*)(A.ws + WS_SLOT))
#define P_tok ((int*)(A.ws + WS_TOK))
#define P_WIN ((bf16*)(A.ws + WS_WIN))
#define P_WOUT ((bf16*)(A.ws + WS_WOUT))
#define P_XN ((bf16*)(A.ws + WS_XN))
#define P_QKVU ((bf16*)(A.ws + WS_QKVU))
#define P_MIX ((bf16*)(A.ws + WS_MIX))
#define P_H ((bf16*)(A.ws + WS_H))
#define P_OB ((bf16*)(A.ws + WS_OB))
#define P_W1 ((bf16*)(A.ws + WS_W1))
#define P_W2 ((bf16*)(A.ws + WS_W2))
constexpr int NWAVES = 8;
struct Frame {
    LAS unsigned char* lds;
    volatile LAS unsigned* MISC;
    gu32* ctl;
    int tid, lane, wave, vcu, G;
};

__device__ __forceinline__ void p0_mod(Frame& F, const Args& A) {
    LAS float* cond = (LAS float*)(F.lds);
    LAS float* red = (LAS float*)(F.lds + 16384);
    for (int i = F.tid; i < NB * D; i += NWAVES * 64) { const float cv = P_c[i]; cond[i] = cv / (1.f + __expf(-cv)); }
    __syncthreads();
    const int c4 = F.lane & 31, rs = F.lane >> 5;
    for (int it = F.vcu; it < DEPTH * (MODW / 128); it += F.G) {
        const int l = it / (MODW / 128), cb = it % (MODW / 128);
        f32x4 acc[4];
#pragma unroll
        for (int b = 0; b < 4; ++b) acc[b] = (f32x4){0.f, 0.f, 0.f, 0.f};
        const float* wp = P_w_mod + ((size_t)l * D + 128 * F.wave + rs) * MODW + 128 * cb + 4 * c4;
#pragma unroll 8
        for (int kk = 0; kk < 64; ++kk) {
            const f32x4 wv = *(const f32x4*)(wp + (size_t)(2 * kk) * MODW);
            const int k = 128 * F.wave + 2 * kk + rs;
#pragma unroll
            for (int b = 0; b < 4; ++b) acc[b] += cond[b * D + k] * wv;
        }
#pragma unroll
        for (int b = 0; b < 4; ++b)
#pragma unroll
            for (int i = 0; i < 4; ++i) acc[b][i] += __shfl_xor(acc[b][i], 32);
        if (rs == 0) {
#pragma unroll
            for (int b = 0; b < 4; ++b) *(LAS f32x4*)(red + (F.wave * 4 + b) * 128 + 4 * c4) = acc[b];
        }
        __syncthreads();
        { const int b = F.tid >> 7, col = F.tid & 127; float s = 0.f;
#pragma unroll
          for (int w = 0; w < 8; ++w) s += red[(w * 4 + b) * 128 + col];
          P_mod[((size_t)l * NB + b) * MODW + 128 * cb + col] = s + P_b_mod[(size_t)l * MODW + 128 * cb + col]; }
        __syncthreads();
    }
    __syncthreads();
}
struct TrDesc { const float* src; bf16* dst; int N, pitch; bool f8; };
__device__ __forceinline__ TrDesc tr_decode(const Args& A, int it) {
    constexpr int I_IN = DEPTH * 16 * 64, I_OUT = DEPTH * 16 * 32, I_W1 = DEPTH * NE * 16 * 64, I_W2 = DEPTH * NE * 16 * 32;
    TrDesc d; int r = it;
    if (r < I_W1) { const int le = r >> 10, rr = r & 1023, kb = rr >> 6, nb = rr & 63, n0 = 32 * nb, bj = n0 >> 10, jj = n0 & 1023, drow = 256 * (jj >> 7) + 128 * bj + (jj & 127);
        d.src = P_exp_w1 + (size_t)le * D * 2048 + (size_t)(64 * kb) * 2048 + n0; d.N = 2048; d.pitch = 1024;
#if MOE_FP8
        d.dst = (bf16*)(P_W18 + (size_t)le * 2048 * D + (size_t)drow * 1024 + 64 * kb); d.f8 = true;
#else
        d.dst = P_W1 + (size_t)le * 2048 * D + (size_t)drow * 1024 + 64 * kb; d.f8 = false;
#endif
        return d; }
    r -= I_W1;
    if (r < I_W2) { const int le = r >> 9, rr = r & 511, kb = rr >> 5, nb = rr & 31;
        d.src = P_exp_w2 + (size_t)le * FE * D + (size_t)(64 * kb) * D + 32 * nb; d.N = D; d.pitch = 1024;
#if MOE_FP8
        d.dst = (bf16*)(P_W28 + (size_t)le * D * FE + (size_t)(32 * nb) * 1024 + 64 * kb); d.f8 = true;
#else
        d.dst = P_W2 + (size_t)le * D * FE + (size_t)(32 * nb) * 1024 + 64 * kb; d.f8 = false;
#endif
        return d; }
    r -= I_W2;
    if (r < I_IN) { const int l = r >> 10, rr = r & 1023, kb = rr >> 6, nb = rr & 63, n0 = 32 * nb, g = (n0 & 255) >> 5, drow = (n0 & ~255) + 128 * (g & 1) + 32 * (g >> 1);
        d.src = P_w_in + (size_t)l * D * INW + (size_t)(64 * kb) * INW + n0; d.dst = P_WIN + (size_t)l * INW * D + (size_t)drow * 1024 + 64 * kb; d.N = INW; d.pitch = 1024; d.f8 = false; return d; }
    r -= I_IN;
    if (r < I_OUT) { const int l = r >> 9, rr = r & 511, kb = rr >> 5, nb = rr & 31;
        d.src = P_w_out + (size_t)l * D * D + (size_t)(64 * kb) * D + 32 * nb; d.dst = P_WOUT + (size_t)l * D * D + (size_t)(32 * nb) * 1024 + 64 * kb; d.N = D; d.pitch = 1024; d.f8 = false; return d; }
    r -= I_OUT;
    { const int m = r >> 3, rr = r & 7, kb = rr >> 2, nb = rr & 3;
        d.src = P_pool_w + (size_t)m * PGRP * PGRP + (size_t)(64 * kb) * PGRP + 32 * nb; d.dst = P_PWT + (size_t)m * PGRP * PGRP + (size_t)(32 * nb) * PGRP + 64 * kb; d.N = PGRP; d.pitch = PGRP; d.f8 = false; return d; }
}
__device__ __forceinline__ void p0_convert(Frame& F, const Args& A) {
    LAS float* scr = (LAS float*)(F.lds + RING_OFF + F.wave * 16384);
    const int gw = F.vcu * NWAVES + F.wave, NGW = F.G * NWAVES, lane = F.lane;
    constexpr int NIT = DEPTH * 16 * 64 + DEPTH * 16 * 32 + DEPTH * NE * 16 * 64 + DEPTH * NE * 16 * 32 + DEPTH * 4 * 8;
    float cv[32];
    TrDesc cur = tr_decode(A, gw < NIT ? gw : 0);
    { const float* sp = cur.src + (size_t)(lane >> 5) * cur.N + (lane & 31);
#pragma unroll
      for (int i = 0; i < 32; ++i) cv[i] = sp[(size_t)(2 * i) * cur.N]; }
    for (int it = gw; it < NIT; it += NGW) {
        const int nit = it + NGW; const bool hn = nit < NIT;
        TrDesc nd = tr_decode(A, hn ? nit : it);
        float nv[32];
        { const float* sp = nd.src + (size_t)(lane >> 5) * nd.N + (lane & 31);
#pragma unroll
          for (int i = 0; i < 32; ++i) nv[i] = sp[(size_t)(2 * i) * nd.N]; }
#pragma unroll
        for (int i = 0; i < 32; ++i) scr[(2 * i + (lane >> 5)) * 33 + (lane & 31)] = cv[i];
        LDS_WAIT(); asm volatile("" ::: "memory");
        if (cur.f8) {
            const int n = lane & 31, hf = lane >> 5; const LAS float* s = scr + (32 * hf) * 33 + n; unsigned char* dp = (unsigned char*)cur.dst + (size_t)n * 1024 + 32 * hf;
#pragma unroll
            for (int q = 0; q < 2; ++q) { u32x4 o;
                o.x = pk4_fp8(s[(16 * q + 0) * 33] * FP8_W_SCALE, s[(16 * q + 1) * 33] * FP8_W_SCALE, s[(16 * q + 2) * 33] * FP8_W_SCALE, s[(16 * q + 3) * 33] * FP8_W_SCALE);
                o.y = pk4_fp8(s[(16 * q + 4) * 33] * FP8_W_SCALE, s[(16 * q + 5) * 33] * FP8_W_SCALE, s[(16 * q + 6) * 33] * FP8_W_SCALE, s[(16 * q + 7) * 33] * FP8_W_SCALE);
                o.z = pk4_fp8(s[(16 * q + 8) * 33] * FP8_W_SCALE, s[(16 * q + 9) * 33] * FP8_W_SCALE, s[(16 * q + 10) * 33] * FP8_W_SCALE, s[(16 * q + 11) * 33] * FP8_W_SCALE);
                o.w = pk4_fp8(s[(16 * q + 12) * 33] * FP8_W_SCALE, s[(16 * q + 13) * 33] * FP8_W_SCALE, s[(16 * q + 14) * 33] * FP8_W_SCALE, s[(16 * q + 15) * 33] * FP8_W_SCALE);
                *(GAS u32x4*)(dp + 16 * q) = o; }
        } else { const int c = lane & 7;
#pragma unroll
          for (int j = 0; j < 4; ++j) { const int n = (lane >> 3) + 8 * j; const LAS float* s = scr + (8 * c) * 33 + n;
            u32x4 o; o.x = pk2(s[0 * 33], s[1 * 33]); o.y = pk2(s[2 * 33], s[3 * 33]); o.z = pk2(s[4 * 33], s[5 * 33]); o.w = pk2(s[6 * 33], s[7 * 33]);
            *(GAS u32x4*)(cur.dst + (size_t)n * cur.pitch + 8 * c) = o; } }
        LDS_WAIT(); asm volatile("" ::: "memory");
        cur = nd;
#pragma unroll
        for (int i = 0; i < 32; ++i) cv[i] = nv[i];
    }
    for (int i = (F.vcu * NWAVES * 64 + F.tid); i < DEPTH * NE * D; i += F.G * NWAVES * 64) { const int l = i >> 15, e = (i >> 10) & 31, cc = i & 1023; P_rwT[i] = P_router_w[((size_t)l * D + cc) * NE + e]; }
}

__device__ __forceinline__ int moe_tables(Frame& F, int l) {
    LAS int* X = (LAS int*)(F.lds + XTR_OFF);
    __syncthreads();
    if (F.tid < NE) X[F.tid] = (int)__hip_atomic_load(F.ctl + CW_CNT + 64 * l + F.tid, RLX_AGENT);
    __syncthreads();
    if (F.tid == 0) { int t = 0; for (int e = 0; e < NE; ++e) { X[32 + e] = t; t += (X[e] + 255) >> 8; } X[32 + NE] = t; X[66] = t; }
    __syncthreads();
    if (F.tid < NE) { const int t0 = X[32 + F.tid], t1 = X[33 + F.tid]; for (int t = t0; t < t1; ++t) X[128 + t] = F.tid; }
    __syncthreads();
    return X[66];
}

template <bool COMBINE, bool NORM>
__device__ __forceinline__ void phase_cn(Frame& F, const Args& A, int l) {
    LAS int* X = (LAS int*)(F.lds + XTR_OFF);
    if (COMBINE) (void)moe_tables(F, l - 1);
    const float* xin = (COMBINE || l > 0) ? P_out : P_x;
    for (int rb = F.vcu * NWAVES + F.wave; rb < M / 8; rb += F.G * NWAVES) {
        const int row0 = rb * 8, b = row0 / SEQ;
        f32x4 a[4], s[4], g2v[4];
#pragma unroll
        for (int j = 0; j < 4; ++j) {
            const int c = 4 * F.lane + 256 * j;
            if (NORM) { const f32x4 g = *(const f32x4*)(P_norm1_g + (size_t)l * D + c); const float* mp = P_mod + ((size_t)l * NB + b) * MODW;
                a[j] = g * (*(const f32x4*)(mp + D + c) + 1.0f); s[j] = *(const f32x4*)(mp + c); }
            if (COMBINE) g2v[j] = *(const f32x4*)(P_mod + ((size_t)(l - 1) * NB + b) * MODW + 5 * D + c);
        }
        for (int r = 0; r < 8; ++r) {
            const int row = row0 + r;
            f32x4 xv[4];
#pragma unroll
            for (int j = 0; j < 4; ++j) xv[j] = *(const f32x4*)(xin + (size_t)row * D + 4 * F.lane + 256 * j);
            if (COMBINE) {
                f32x4 y[4];
#pragma unroll
                for (int j = 0; j < 4; ++j) y[j] = (f32x4){0.f, 0.f, 0.f, 0.f};
#pragma unroll
                for (int k = 0; k < TOPK; ++k) {
                    const int so = P_slot[row * 4 + k]; const float gt = P_gate[row * 4 + k];
                    const int e = so >> 14, pos = so & 16383; const size_t orow = (size_t)X[32 + e] * 256 + pos;
#pragma unroll
                    for (int j = 0; j < 4; ++j) { const u32x2 w = *(const u32x2*)(P_OB + orow * D + 4 * F.lane + 256 * j);
                        y[j] += gt * (f32x4){bflo(w.x), bfhi(w.x), bflo(w.y), bfhi(w.y)}; }
                }
#pragma unroll
                for (int j = 0; j < 4; ++j) { xv[j] += g2v[j] * y[j]; *(f32x4*)(P_out + (size_t)row * D + 4 * F.lane + 256 * j) = xv[j]; }
            }
            if (NORM) {
                float ss = 0.f;
#pragma unroll
                for (int j = 0; j < 4; ++j) ss += (xv[j][0] * xv[j][0] + xv[j][1] * xv[j][1]) + (xv[j][2] * xv[j][2] + xv[j][3] * xv[j][3]);
                const float rstd = __builtin_amdgcn_rsqf(wave_sum(ss) * (1.f / D) + EPS);
#pragma unroll
                for (int j = 0; j < 4; ++j) { const f32x4 h = xv[j] * rstd * a[j] + s[j]; u32x2 w; w.x = pk2(h[0], h[1]); w.y = pk2(h[2], h[3]);
                    *(u32x2*)(P_XN + (size_t)row * D + 4 * F.lane + 256 * j) = w; }
            }
        }
    }
}

__device__ __forceinline__ void argmax_wave(float& v, int& e) {
#pragma unroll
    for (int o = 32; o >= 1; o >>= 1) { const float ov = __shfl_xor(v, o); const int oe = __shfl_xor(e, o); if (ov > v || (ov == v && oe < e)) { v = ov; e = oe; } }
}
__device__ __forceinline__ void phase_router(Frame& F, const Args& A, int l) {
    LAS f32x4* rw = (LAS f32x4*)F.lds;
    LAS int* X = (LAS int*)(F.lds + XTR_OFF);
    { const f32x4* src = (const f32x4*)(P_rwT + (size_t)l * NE * D); for (int i = F.tid; i < NE * D / 4; i += NWAVES * 64) rw[i] = src[i]; }
    if (F.tid < NE) X[F.tid] = 0;
    __syncthreads();
    for (int rb = F.vcu; rb < M / 64; rb += F.G) {
        const int row0 = rb * 64 + F.wave * 8, b = row0 / SEQ;
        f32x4 a[4], s[4];
#pragma unroll
        for (int j = 0; j < 4; ++j) { const int c = 4 * F.lane + 256 * j; const f32x4 g = *(const f32x4*)(P_norm2_g + (size_t)l * D + c); const float* mp = P_mod + ((size_t)l * NB + b) * MODW;
            a[j] = g * (*(const f32x4*)(mp + 4 * D + c) + 1.0f); s[j] = *(const f32x4*)(mp + 3 * D + c); }
        for (int pr = 0; pr < 4; ++pr) {
            f32x4 h[2][4];
#pragma unroll
            for (int r = 0; r < 2; ++r) {
                const int row = row0 + 2 * pr + r;
                float ss = 0.f;
#pragma unroll
                for (int j = 0; j < 4; ++j) { h[r][j] = *(const f32x4*)(P_out + (size_t)row * D + 4 * F.lane + 256 * j); ss += (h[r][j][0] * h[r][j][0] + h[r][j][1] * h[r][j][1]) + (h[r][j][2] * h[r][j][2] + h[r][j][3] * h[r][j][3]); }
                const float rstd = __builtin_amdgcn_rsqf(wave_sum(ss) * (1.f / D) + EPS);
#pragma unroll
                for (int j = 0; j < 4; ++j) { h[r][j] = h[r][j] * rstd * a[j] + s[j];
#if MOE_FP8
                    *(unsigned*)(P_XN8 + (size_t)row * D + 4 * F.lane + 256 * j) = pk4_fp8(h[r][j][0] * FP8_ACT_SCALE, h[r][j][1] * FP8_ACT_SCALE, h[r][j][2] * FP8_ACT_SCALE, h[r][j][3] * FP8_ACT_SCALE);
#else
                    u32x2 w; w.x = pk2(h[r][j][0], h[r][j][1]); w.y = pk2(h[r][j][2], h[r][j][3]);
                    *(u32x2*)(P_XN + (size_t)row * D + 4 * F.lane + 256 * j) = w;
#endif
                }
            }
            float t16[2][16];
            { const bool up32 = (F.lane & 32) != 0;
#pragma unroll
              for (int i = 0; i < 16; ++i) {
                float pl0 = 0.f, pl1 = 0.f, ph0 = 0.f, ph1 = 0.f;
#pragma unroll
                for (int j = 0; j < 4; ++j) { const f32x4 wl = rw[i * 256 + 64 * j + F.lane], wh = rw[(i + 16) * 256 + 64 * j + F.lane];
                    pl0 += (h[0][j][0] * wl[0] + h[0][j][1] * wl[1]) + (h[0][j][2] * wl[2] + h[0][j][3] * wl[3]);
                    pl1 += (h[1][j][0] * wl[0] + h[1][j][1] * wl[1]) + (h[1][j][2] * wl[2] + h[1][j][3] * wl[3]);
                    ph0 += (h[0][j][0] * wh[0] + h[0][j][1] * wh[1]) + (h[0][j][2] * wh[2] + h[0][j][3] * wh[3]);
                    ph1 += (h[1][j][0] * wh[0] + h[1][j][1] * wh[1]) + (h[1][j][2] * wh[2] + h[1][j][3] * wh[3]); }
                t16[0][i] = (up32 ? ph0 : pl0) + __shfl_xor(up32 ? pl0 : ph0, 32);
                t16[1][i] = (up32 ? ph1 : pl1) + __shfl_xor(up32 ? pl1 : ph1, 32);
                asm volatile("" ::: "memory"); __builtin_amdgcn_sched_barrier(0);
              } }
#pragma unroll
            for (int r = 0; r < 2; ++r) {
                float t8[8], t4[4], t2[2];
                { const bool up = (F.lane & 16) != 0;
#pragma unroll
                  for (int i = 0; i < 8; ++i) { const float lo = t16[r][i], hi = t16[r][i + 8]; t8[i] = (up ? hi : lo) + __shfl_xor(up ? lo : hi, 16); } }
                { const bool up = (F.lane & 8) != 0;
#pragma unroll
                  for (int i = 0; i < 4; ++i) { const float lo = t8[i], hi = t8[i + 4]; t4[i] = (up ? hi : lo) + __shfl_xor(up ? lo : hi, 8); } }
                { const bool up = (F.lane & 4) != 0;
#pragma unroll
                  for (int i = 0; i < 2; ++i) { const float lo = t4[i], hi = t4[i + 2]; t2[i] = (up ? hi : lo) + __shfl_xor(up ? lo : hi, 4); } }
                float v;
                { const bool up = (F.lane & 2) != 0; const float lo = t2[0], hi = t2[1]; v = (up ? hi : lo) + __shfl_xor(up ? lo : hi, 2); }
                v += __shfl_xor(v, 1);
                const int me = F.lane >> 1;
                v += P_router_b[l * NE + me];
                float tv[4]; int te[4]; float cv = v;
#pragma unroll
                for (int k = 0; k < 4; ++k) { float bv = cv; int be = me; argmax_wave(bv, be); tv[k] = bv; te[k] = be; if (me == be) cv = -3.0e38f; }
                const float e1 = __expf(tv[1] - tv[0]), e2 = __expf(tv[2] - tv[0]), e3 = __expf(tv[3] - tv[0]); const float inv = 1.0f / (1.0f + e1 + e2 + e3);
                if (F.lane < 4) {
                    const int my_e = F.lane == 0 ? te[0] : F.lane == 1 ? te[1] : F.lane == 2 ? te[2] : te[3];
                    const float my_g = (F.lane == 0 ? 1.0f : F.lane == 1 ? e1 : F.lane == 2 ? e2 : e3) * inv;
                    const int lr = __hip_atomic_fetch_add(&X[my_e], 1, __ATOMIC_RELAXED, __HIP_MEMORY_SCOPE_WORKGROUP);
                    const int rl = F.wave * 8 + 2 * pr + r;
                    X[64 + rl * 4 + F.lane] = my_e | (lr << 8);
                    P_gate[(size_t)(rb * 64 + rl) * 4 + F.lane] = my_g;
                }
            }
        }
        __syncthreads();
        if (F.tid < NE) X[32 + F.tid] = (int)__hip_atomic_fetch_add(F.ctl + CW_CNT + 64 * l + F.tid, (unsigned)X[F.tid], RLX_AGENT);
        __syncthreads();
        if (F.tid < 256) { const int rl = F.tid >> 2, sv = X[64 + F.tid], e = sv & 255, lr = sv >> 8, pos = X[32 + e] + lr, row = rb * 64 + rl;
            P_tok[e * M + pos] = row; P_slot[row * 4 + (F.tid & 3)] = (e << 14) | pos; }
        __syncthreads();
        if (F.tid < NE) X[F.tid] = 0;
        __syncthreads();
    }
}


typedef float f32x16 __attribute__((ext_vector_type(16)));
typedef short s16x4 __attribute__((ext_vector_type(4)));
__device__ __forceinline__ s16x4 lds_tr16(LAS unsigned char* p) { return __builtin_bit_cast(s16x4, __builtin_amdgcn_ds_read_tr16_b64_v4i16((LAS s16x4*)p)); }
#define ATT_GLDS(gp, lp) __builtin_amdgcn_global_load_lds((const unsigned*)(gp), (LAS unsigned*)(lp), 16, 0, 0)
__device__ __forceinline__ void phase_attn(Frame& F, const Args& A, int l) {
    LAS unsigned char* wl = F.lds + F.wave * 16384;
    LAS float* bt = (LAS float*)(F.lds + XTR_OFF) + F.wave * 320;
    const int lane = F.lane, r = lane & 31, hh = lane >> 5;
    __syncthreads();
    unsigned koffE, koffO, voff0;
    { const int row = lane >> 3, cp = lane & 7, ck = cp ^ ((row >> 1) & 7), cv = cp ^ (4 * ((row >> 1) & 1));
      koffE = (unsigned)(row * INW * 2 + ck * 16); koffO = (unsigned)(row * INW * 2 + (ck ^ 4) * 16); voff0 = (unsigned)(row * INW * 2 + AW * 2 + cv * 16); }
    unsigned kaddr0;
    { const int cp = hh ^ ((r >> 1) & 7); kaddr0 = (unsigned)(r * 128 + cp * 16); }
    unsigned vaddr[2];
    { const int li = lane & 15, q4 = li >> 2, p4 = li & 3, g = (lane >> 4) & 1;
#pragma unroll
      for (int db = 0; db < 2; ++db) { const int cp = 4 * (db ^ (q4 >> 1)) + 2 * g + (p4 >> 1); vaddr[db] = (unsigned)(4096 + (4 * hh + q4) * 128 + cp * 16 + 8 * (p4 & 1)); } }
    for (int uw = F.vcu * NWAVES + F.wave; uw < NB * NH * NCH; uw += F.G * NWAVES) {
        const int bh = uw >> 6, n = uw & 63, b = bh >> 3, h = bh & 7;
        { float v[5]; float mb = -3.0e38f;
#pragma unroll
          for (int i = 0; i < 5; ++i) { const int idx = lane + 64 * i; v[i] = idx < 257 ? P_rel_bias[((size_t)l * NH + h) * 257 + idx] * LOG2E : -3.0e38f; mb = fmaxf(mb, v[i]); }
#pragma unroll
          for (int o = 1; o < 64; o <<= 1) mb = fmaxf(mb, __shfl_xor(mb, o));
#pragma unroll
          for (int i = 0; i < 5; ++i) { const int idx = lane + 64 * i; if (idx < 257) bt[idx] = v[i] - mb; } }
        LDS_WAIT(); asm volatile("" ::: "memory");
        const int jlo = n >= LEFTC ? n - LEFTC : 0, NT = 2 * (n - jlo + 1);
        const char* kb0 = (const char*)(P_QKVU + (size_t)(b * SEQ + CHUNK * jlo) * INW + AW + h * HD);
#define ATT_ISSUE(t) do { const char* kb_ = kb0 + (size_t)(t) * 32 * INW * 2; LAS unsigned char* lb_ = wl + ((t) & 1) * 8192; \
        _Pragma("unroll") for (int i_ = 0; i_ < 4; ++i_) ATT_GLDS(kb_ + (size_t)i_ * 8 * INW * 2 + ((i_ & 1) ? koffO : koffE), lb_ + i_ * 1024); \
        _Pragma("unroll") for (int i_ = 0; i_ < 4; ++i_) ATT_GLDS(kb_ + (size_t)i_ * 8 * INW * 2 + voff0, lb_ + 4096 + i_ * 1024); } while (0)
        ATT_ISSUE(0);
        bf16x8 qf[2][4];
        { const bf16* qp = P_QKVU + (size_t)(b * SEQ + CHUNK * n + r) * INW + h * HD + 8 * hh;
#pragma unroll
          for (int qb = 0; qb < 2; ++qb)
#pragma unroll
            for (int d0 = 0; d0 < 4; ++d0) qf[qb][d0] = *(const bf16x8*)(qp + (size_t)qb * 32 * INW + 16 * d0); }
        f32x16 o[2][2]; float lsum[2] = {0.f, 0.f};
#pragma unroll
        for (int qb = 0; qb < 2; ++qb)
#pragma unroll
            for (int db = 0; db < 2; ++db)
#pragma unroll
                for (int i = 0; i < 16; ++i) o[qb][db][i] = 0.f;
#pragma unroll 1
        for (int t = 0; t < NT; ++t) {
            if (t + 1 < NT) { ATT_ISSUE(t + 1); asm volatile("s_waitcnt vmcnt(8)" ::: "memory"); } else { asm volatile("s_waitcnt vmcnt(0)" ::: "memory"); }
            LAS unsigned char* tb = wl + (t & 1) * 8192;
            bf16x8 kf[4];
#pragma unroll
            for (int d0 = 0; d0 < 4; ++d0) kf[d0] = *(const LAS bf16x8*)(tb + (kaddr0 ^ (unsigned)(d0 << 5)));
            const int jj = jlo + (t >> 1) - (n - LEFTC), th = t & 1;
            bf16x8 pf[2][2];
#pragma unroll
            for (int qb = 0; qb < 2; ++qb) {
                f32x16 s;
                if (jj <= 5) { const float c0 = bt[0];
#pragma unroll
                    for (int i = 0; i < 16; ++i) s[i] = c0;
                } else {
                    const int relb = (jj - LEFTC) * CHUNK + 32 * th + 4 * hh - 32 * qb - r;
#pragma unroll
                    for (int i = 0; i < 16; ++i) { int rel = relb + (i & 3) + 8 * (i >> 2); rel = rel < -128 ? -128 : (rel > 128 ? 128 : rel); s[i] = bt[rel + 128]; }
                }
#pragma unroll
                for (int d0 = 0; d0 < 4; ++d0) s = __builtin_amdgcn_mfma_f32_32x32x16_bf16(kf[d0], qf[qb][d0], s, 0, 0, 0);
                float ls = 0.f;
#pragma unroll
                for (int i = 0; i < 16; ++i) { s[i] = __builtin_amdgcn_exp2f(s[i]); ls += s[i]; }
                lsum[qb] += ls;
#pragma unroll
                for (int st = 0; st < 2; ++st) { u32x4 w; w.x = cvt_pk_bf16(s[8 * st + 0], s[8 * st + 1]); w.y = cvt_pk_bf16(s[8 * st + 2], s[8 * st + 3]); w.z = cvt_pk_bf16(s[8 * st + 4], s[8 * st + 5]); w.w = cvt_pk_bf16(s[8 * st + 6], s[8 * st + 7]);
                    pf[qb][st] = __builtin_bit_cast(bf16x8, w); }
                __builtin_amdgcn_sched_barrier(0);
            }
#pragma unroll
            for (int db = 0; db < 2; ++db)
#pragma unroll
                for (int st = 0; st < 2; ++st) {
                    const s16x4 lo = lds_tr16(tb + vaddr[db] + st * 2048), hi = lds_tr16(tb + vaddr[db] + st * 2048 + 1024);
                    const bf16x8 vf = (bf16x8){lo[0], lo[1], lo[2], lo[3], hi[0], hi[1], hi[2], hi[3]};
#pragma unroll
                    for (int qb = 0; qb < 2; ++qb) o[qb][db] = __builtin_amdgcn_mfma_f32_32x32x16_bf16(vf, pf[qb][st], o[qb][db], 0, 0, 0);
                }
            LDS_WAIT(); asm volatile("" ::: "memory");
        }
#undef ATT_ISSUE
#pragma unroll
        for (int qb = 0; qb < 2; ++qb) {
            const float lt = lsum[qb] + __shfl_xor(lsum[qb], 32); const float il = 1.0f / lt;
            bf16* op = P_MIX + (size_t)(b * SEQ + CHUNK * n + 32 * qb + r) * D + h * HD + 4 * hh;
#pragma unroll
            for (int db = 0; db < 2; ++db)
#pragma unroll
                for (int g4 = 0; g4 < 4; ++g4) { u32x2 w; w.x = cvt_pk_bf16(o[qb][db][4 * g4 + 0] * il, o[qb][db][4 * g4 + 1] * il); w.y = cvt_pk_bf16(o[qb][db][4 * g4 + 2] * il, o[qb][db][4 * g4 + 3] * il);
                    *(u32x2*)(op + 32 * db + 8 * g4) = w; }
        }
    }
    __syncthreads();
}
template <int W>
__device__ __forceinline__ void pool_dtile(const bf16* up, int t0, LAS unsigned char* wl, int lane) {
    unsigned hist[W - 1], cur[32];
#pragma unroll
    for (int k = 0; k < W - 1; ++k) hist[k] = (t0 - (W - 1) + k >= 0) ? *(const unsigned*)(up - (size_t)(W - 1 - k) * INW) : 0u;
#pragma unroll
    for (int i = 0; i < 32; ++i) cur[i] = *(const unsigned*)(up + (size_t)i * INW);
    float s0 = 0.f, s1 = 0.f;
#pragma unroll
    for (int k = 0; k < W - 1; ++k) { s0 += bflo(hist[k]); s1 += bfhi(hist[k]); }
#pragma unroll
    for (int i = 0; i < 32; ++i) {
        const float u0 = bflo(cur[i]), u1 = bfhi(cur[i]);
        s0 += u0; s1 += u1;
        const int tp = t0 + i; const float ic = (tp + 1) < W ? 1.0f / (float)(tp + 1) : 1.0f / (float)W;
        *(LAS unsigned*)(wl + i * 256 + 4 * lane) = pk2(s0 * ic - u0, s1 * ic - u1);
        const unsigned vo = (i - W + 1 >= 0) ? cur[(i - W + 1 >= 0) ? (i - W + 1) : 0] : hist[(i < W - 1) ? i : 0];
        s0 -= bflo(vo); s1 -= bfhi(vo);
    }
}
__device__ __forceinline__ void phase_pool(Frame& F, const Args& A, int l) {
    LAS unsigned char* wl = F.lds + F.wave * 16384;
    const int lane = F.lane, r = lane & 31, hh = lane >> 5;
    __syncthreads();
    for (int uw = F.vcu * NWAVES + F.wave; uw < (M / 32) * 4; uw += F.G * NWAVES) {
        const int g = uw & 3, rb = uw >> 2, row0 = rb * 32, t0 = row0 % SEQ;
        const bf16* up = P_QKVU + (size_t)row0 * INW + 3 * AW + g * PGRP + 2 * lane;
        if (g == 0) pool_dtile<2>(up, t0, wl, lane); else if (g == 1) pool_dtile<4>(up, t0, wl, lane); else if (g == 2) pool_dtile<8>(up, t0, wl, lane); else pool_dtile<16>(up, t0, wl, lane);
        LDS_WAIT(); asm volatile("" ::: "memory");
        bf16x8 df[8];
#pragma unroll
        for (int st = 0; st < 8; ++st) df[st] = *(const LAS bf16x8*)(wl + r * 256 + 32 * st + 16 * hh);
        const bf16* wt = P_PWT + ((size_t)(l * 4 + g) * PGRP + r) * PGRP + 8 * hh;
        const float* pb = P_pool_b + l * 512 + g * PGRP + 4 * hh; const float* ps = P_pool_scale + l * 512 + g * PGRP + 4 * hh;
        bf16* op = P_MIX + (size_t)(row0 + r) * D + AW + g * PGRP + 4 * hh;
#pragma unroll 2
        for (int jb = 0; jb < 4; ++jb) {
            f32x16 acc;
#pragma unroll
            for (int i = 0; i < 16; ++i) acc[i] = 0.f;
#pragma unroll
            for (int st = 0; st < 8; ++st) { const bf16x8 wf = *(const bf16x8*)(wt + (size_t)jb * 32 * PGRP + 16 * st); acc = __builtin_amdgcn_mfma_f32_32x32x16_bf16(wf, df[st], acc, 0, 0, 0); }
#pragma unroll
            for (int g4 = 0; g4 < 4; ++g4) { const f32x4 bv = *(const f32x4*)(pb + 32 * jb + 8 * g4), sv = *(const f32x4*)(ps + 32 * jb + 8 * g4);
                u32x2 wv; wv.x = cvt_pk_bf16((acc[4 * g4 + 0] + bv[0]) * sv[0], (acc[4 * g4 + 1] + bv[1]) * sv[1]); wv.y = cvt_pk_bf16((acc[4 * g4 + 2] + bv[2]) * sv[2], (acc[4 * g4 + 3] + bv[3]) * sv[3]);
                *(u32x2*)(op + 32 * jb + 8 * g4) = wv; }
        }
        LDS_WAIT(); asm volatile("" ::: "memory");
    }
    __syncthreads();
}

__device__ __forceinline__ void phase_attn_naive(Frame& F, const Args& A, int l) {
    LAS unsigned char* kt = F.lds + F.wave * 16384;
    LAS float* bt = (LAS float*)(F.lds + XTR_OFF) + F.wave * 320;
    const int h = F.wave;
    __syncthreads();
    for (int i = F.lane; i < 257; i += 64) bt[i] = P_rel_bias[((size_t)l * NH + h) * 257 + i] * LOG2E;
    LDS_WAIT();
    const int hf = F.lane >> 5, d0 = 32 * hf;
    for (int un = F.vcu; un < NB * NCH; un += F.G) {
        const int b = un / NCH, n = un % NCH;
#pragma unroll 1
        for (int pass = 0; pass < 2; ++pass) {
            const int qi = 32 * pass + (F.lane & 31); const int qrow = b * SEQ + n * CHUNK + qi;
            float q[32], o[32];
            { const u32x4* qp = (const u32x4*)(P_QKVU + (size_t)qrow * INW + h * HD + d0);
#pragma unroll
              for (int c = 0; c < 4; ++c) { const u32x4 w = qp[c]; q[8 * c + 0] = bflo(w.x); q[8 * c + 1] = bfhi(w.x); q[8 * c + 2] = bflo(w.y); q[8 * c + 3] = bfhi(w.y); q[8 * c + 4] = bflo(w.z); q[8 * c + 5] = bfhi(w.z); q[8 * c + 6] = bflo(w.w); q[8 * c + 7] = bfhi(w.w); } }
#pragma unroll
            for (int d = 0; d < 32; ++d) o[d] = 0.f;
            float mrun = -1.0e30f, lrun = 0.f;
#pragma unroll 1
            for (int jj = (n >= LEFTC ? 0 : LEFTC - n); jj <= LEFTC; ++jj) {
                const int krow = b * SEQ + (n - LEFTC + jj) * CHUNK + F.lane;
                { const u32x4* kp = (const u32x4*)(P_QKVU + (size_t)krow * INW + AW + h * HD); const u32x4* vp = (const u32x4*)(P_QKVU + (size_t)krow * INW + 2 * AW + h * HD);
#pragma unroll
                  for (int c = 0; c < 8; ++c) { *(LAS u32x4*)(kt + F.lane * 128 + 16 * c) = kp[c]; *(LAS u32x4*)(kt + 8192 + F.lane * 128 + 16 * c) = vp[c]; } }
                LDS_WAIT(); asm volatile("" ::: "memory");
#pragma unroll 1
                for (int key = 0; key < 64; ++key) {
                    float acc = 0.f;
#pragma unroll
                    for (int c = 0; c < 4; ++c) { const u32x4 w = *(const LAS u32x4*)(kt + key * 128 + 2 * d0 + 16 * c);
                        acc += q[8 * c + 0] * bflo(w.x) + q[8 * c + 1] * bfhi(w.x) + q[8 * c + 2] * bflo(w.y) + q[8 * c + 3] * bfhi(w.y) + q[8 * c + 4] * bflo(w.z) + q[8 * c + 5] * bfhi(w.z) + q[8 * c + 6] * bflo(w.w) + q[8 * c + 7] * bfhi(w.w); }
                    acc += __shfl_xor(acc, 32);
                    int rel = (jj - LEFTC) * CHUNK + key - qi; rel = rel < -128 ? -128 : (rel > 128 ? 128 : rel);
                    const float sc = acc + bt[rel + 128];
                    const float mnew = fmaxf(mrun, sc), alpha = __builtin_amdgcn_exp2f(mrun - mnew), p = __builtin_amdgcn_exp2f(sc - mnew);
                    mrun = mnew; lrun = lrun * alpha + p;
#pragma unroll
                    for (int c = 0; c < 4; ++c) { const u32x4 w = *(const LAS u32x4*)(kt + 8192 + key * 128 + 2 * d0 + 16 * c);
                        o[8 * c + 0] = o[8 * c + 0] * alpha + p * bflo(w.x); o[8 * c + 1] = o[8 * c + 1] * alpha + p * bfhi(w.x); o[8 * c + 2] = o[8 * c + 2] * alpha + p * bflo(w.y); o[8 * c + 3] = o[8 * c + 3] * alpha + p * bfhi(w.y);
                        o[8 * c + 4] = o[8 * c + 4] * alpha + p * bflo(w.z); o[8 * c + 5] = o[8 * c + 5] * alpha + p * bfhi(w.z); o[8 * c + 6] = o[8 * c + 6] * alpha + p * bflo(w.w); o[8 * c + 7] = o[8 * c + 7] * alpha + p * bfhi(w.w); }
                }
                LDS_WAIT(); asm volatile("" ::: "memory");
            }
            const float il = 1.0f / lrun;
            { u32x4* op = (u32x4*)(P_MIX + (size_t)qrow * D + h * HD + d0);
#pragma unroll
              for (int c = 0; c < 4; ++c) { u32x4 w; w.x = pk2(o[8 * c + 0] * il, o[8 * c + 1] * il); w.y = pk2(o[8 * c + 2] * il, o[8 * c + 3] * il); w.z = pk2(o[8 * c + 4] * il, o[8 * c + 5] * il); w.w = pk2(o[8 * c + 6] * il, o[8 * c + 7] * il); op[c] = w; } }
        }
    }
    __syncthreads();
}
__device__ __forceinline__ void phase_pool_naive(Frame& F, const Args& A, int l) {
    LAS float* dl = (LAS float*)F.lds;
    __syncthreads();
    for (int un = F.vcu; un < (M / 64) * 4; un += F.G) {
        const int rb = un >> 2, g = un & 3, w = 2 << g;
        { const int c = F.tid & 127, r0 = F.tid >> 7;
          for (int i = 0; i < 16; ++i) { const int r = r0 + 4 * i, row = rb * 64 + r, tpos = row % SEQ; const int cnt = (tpos + 1) < w ? (tpos + 1) : w;
              float sum = 0.f; for (int s = 0; s < cnt; ++s) sum += bflo((unsigned)P_QKVU[(size_t)(row - s) * INW + 3 * AW + g * PGRP + c]);
              const float ut = bflo((unsigned)P_QKVU[(size_t)row * INW + 3 * AW + g * PGRP + c]);
              dl[r * 129 + c] = sum / (float)cnt - ut; } }
        __syncthreads();
        { const int j = F.tid & 127, rq = F.tid >> 7; float acc[16];
#pragma unroll
          for (int i = 0; i < 16; ++i) acc[i] = 0.f;
          const float* pw = P_pool_w + ((size_t)(l * 4 + g) * PGRP) * PGRP + j;
          for (int c = 0; c < PGRP; ++c) { const float wv = pw[(size_t)c * PGRP];
#pragma unroll
              for (int i = 0; i < 16; ++i) acc[i] += dl[(rq + 4 * i) * 129 + c] * wv; }
          const float pb = P_pool_b[l * 512 + g * PGRP + j], ps = P_pool_scale[l * 512 + g * PGRP + j];
#pragma unroll
          for (int i = 0; i < 16; ++i) P_MIX[(size_t)(rb * 64 + rq + 4 * i) * D + AW + g * PGRP + j] = (bf16)f2bf((acc[i] + pb) * ps); }
        __syncthreads();
    }
}

constexpr int NSTEP = 1 + 7 * DEPTH + 1;

__global__ void __launch_bounds__(NWAVES * 64, 2) mk_fwd(Args args) {
    const Args& A = args;
    extern __shared__ __attribute__((aligned(16))) unsigned char lds[];
    Frame F;
    F.lds = (LAS unsigned char*)lds;
    F.MISC = (volatile LAS unsigned*)(F.lds + LDSCTL_OFF);
    F.tid = threadIdx.x; F.lane = F.tid & 63; F.wave = __builtin_amdgcn_readfirstlane(F.tid >> 6);
    F.G = gridDim.x; { const int bx = blockIdx.x; F.vcu = (F.G % 8 == 0) ? (bx % 8) * (F.G / 8) + bx / 8 : bx; }
    unsigned char* ws = args.ws;
    F.ctl = (gu32*)(ws + WS_CTL);
    for (int u = F.tid; u < 128; u += NWAVES * 64) ((LAS unsigned*)(F.lds + LDSCTL_OFF))[u] = 0u;
    __syncthreads();
    XcdBarrier bar; bar.bar = (unsigned*)(F.ctl + CW_BAR + args.li * BAR_STRIDE); bar.x = 0; bar.st = nullptr;
#if MK_ONE_LAUNCH && PROBE_STEP < 0
    constexpr int lo = 0, hi = NSTEP;
#else
    const int lo = args.s_lo, hi = args.s_hi;
#endif
    if (hi - lo > 1) bar = xcd_barrier_post((unsigned*)(F.ctl + CW_BAR + args.li * BAR_STRIDE), F.MISC + 8);
#define IN(k) (lo <= (k) && (k) < hi)
#define OPAQUE() do { asm volatile("" : "+v"(F.tid)); F.lane = F.tid & 63; F.wave = __builtin_amdgcn_readfirstlane(F.tid >> 6); } while (0)
#define SEAM(k) do { if (IN(k) && IN((k) + 1)) { XcdBarrier b2_ = bar; asm volatile("" : "+s"(b2_.bar), "+s"(b2_.x)); xcd_barrier(b2_); } } while (0)

    if (IN(0)) { OPAQUE(); p0_mod(F, args); p0_convert(F, args); SEAM(0); }

    for (int l = 0; l < DEPTH; ++l) {
        const int sb = 1 + 7 * l;
        if (IN(sb + 0)) { OPAQUE(); if (l == 0) phase_cn<false, true>(F, args, l); else phase_cn<true, true>(F, args, l); SEAM(sb + 0); }
        if (IN(sb + 1)) { OPAQUE();
            pg8::DenseOrder S; S.init(M, INW, F.G, (int)blockIdx.x, P_XN, P_WIN + (size_t)l * INW * D);
            pg8::EpiWin E{P_QKVU, P_q_g + l * HD, P_k_g + l * HD};
            pg8::gemm_phase<pg8::EpiWin, pg8::DenseOrder, true>(F.lds + RING_OFF, S, E);
            SEAM(sb + 1);
        }
        if (IN(sb + 2)) {
#if ATTN_NAIVE
            OPAQUE(); phase_attn_naive(F, args, l);
#else
            if (!(args.opt & 2)) { OPAQUE(); phase_attn(F, args, l); }
#endif
#if POOL_NAIVE
            OPAQUE(); phase_pool_naive(F, args, l);
#else
            if (!(args.opt & 1)) { OPAQUE(); phase_pool(F, args, l); }
#endif
            SEAM(sb + 2); }
        if (IN(sb + 3)) { OPAQUE();
            pg8::DenseOrder S; S.init(M, D, F.G, (int)blockIdx.x, P_MIX, P_WOUT + (size_t)l * D * D);
            pg8::EpiWout E{l == 0 ? P_x : P_out, P_out, P_mod + (size_t)l * NB * MODW + 2 * D};
            pg8::gemm_phase<pg8::EpiWout, pg8::DenseOrder, true>(F.lds + RING_OFF, S, E);
            SEAM(sb + 3);
        }
        if (IN(sb + 4)) { OPAQUE(); phase_router(F, args, l); SEAM(sb + 4); }
        if (IN(sb + 5)) { OPAQUE();
            const int T = moe_tables(F, l);
            LAS int* X = (LAS int*)(F.lds + XTR_OFF);
            pg8::MoeOrder<true, MOE_FP8 ? 1 : 2> S; S.tile_e = X + 128; S.toff = (const LAS unsigned*)(X + 512); S.T = T; S.vcu = F.vcu; S.G = F.G; S.ncol = 8; S.rpb = 4;
#if MOE_FP8
            constexpr int MEB = 1; S.A = (const char*)P_XN8; S.B = (const char*)(P_W18 + (size_t)l * NE * 2048 * D);
#else
            constexpr int MEB = 2; S.A = (const char*)P_XN; S.B = (const char*)(P_W1 + (size_t)l * NE * 2048 * D);
#endif
            S.estride = (size_t)2048 * D * MEB; S.tstep = (size_t)256 * D * MEB;
            { pg8::GUnit u; for (int i = 0; i < MAXU && S.next(i, u); ++i) { if (F.tid < 256) { const int e = u.e, base = u.row0 - X[32 + e] * 256 + F.tid, cnt = X[e]; const int idx = base < cnt ? base : cnt - 1;
                    ((LAS unsigned*)(X + 512))[i * 256 + F.tid] = (unsigned)P_tok[e * M + idx] * (unsigned)(D * MEB); } } }
            __syncthreads();
            pg8::EpiSwiglu E{P_H, P_exp_b1 + (size_t)l * NE * 2048};
            pg8::gemm_phase<pg8::EpiSwiglu, pg8::MoeOrder<true, MEB>, true, MEB>(F.lds + RING_OFF, S, E);
            SEAM(sb + 5);
        }
        if (IN(sb + 6)) { OPAQUE();
            const int T = moe_tables(F, l);
            LAS int* X = (LAS int*)(F.lds + XTR_OFF);
            pg8::MoeOrder<false, MOE_FP8 ? 1 : 2> S; S.tile_e = X + 128; S.toff = (const LAS unsigned*)(X + 512); S.T = T; S.vcu = F.vcu; S.G = F.G; S.ncol = 4; S.rpb = 8;
#if MOE_FP8
            constexpr int MEB = 1; S.A = (const char*)P_H8; S.B = (const char*)(P_W28 + (size_t)l * NE * D * FE);
#else
            constexpr int MEB = 2; S.A = (const char*)P_H; S.B = (const char*)(P_W2 + (size_t)l * NE * D * FE);
#endif
            S.estride = (size_t)D * FE * MEB; S.tstep = (size_t)256 * D * MEB;
            pg8::EpiOB E{P_OB, P_exp_b2 + (size_t)l * NE * D};
            pg8::gemm_phase<pg8::EpiOB, pg8::MoeOrder<false, MEB>, true, MEB>(F.lds + RING_OFF, S, E);
            SEAM(sb + 6);
        }
    }
    if (IN(NSTEP - 1)) { OPAQUE(); phase_cn<true, false>(F, args, DEPTH); }
#undef IN
#undef OPAQUE
#undef SEAM
}

extern "C" void kernel_launch(void* const* d_in, const int* in_sizes, int n_in, void* d_out, int out_size, void* d_ws, size_t ws_size, hipStream_t stream) {
    static int grid = 0;
    if (grid == 0) {
        if (n_in != 20 || in_sizes[0] != M * D || out_size != M * D || ws_size < WS_END) { fprintf(stderr, "kernel_launch: unexpected shapes / workspace (n_in %d, ws %zu)\n", n_in, ws_size); grid = -1; return; }
        int dev = 0, cus = 0, per_cu = 0;
        if (hipGetDevice(&dev) != hipSuccess || hipDeviceGetAttribute(&cus, hipDeviceAttributeMultiprocessorCount, dev) != hipSuccess) { grid = -1; return; }
        if (hipFuncSetAttribute((const void*)mk_fwd, hipFuncAttributeMaxDynamicSharedMemorySize, LDS_BYTES) != hipSuccess) { fprintf(stderr, "kernel_launch: hipFuncSetAttribute failed\n"); grid = -1; return; }
        if (hipOccupancyMaxActiveBlocksPerMultiprocessor(&per_cu, (const void*)mk_fwd, NWAVES * 64, LDS_BYTES) != hipSuccess || per_cu < 1) fprintf(stderr, "kernel_launch: occupancy query reports %d\n", per_cu);
        (void)hipGetLastError();
        grid = cus;
    }
    if (grid < 0) return;
    if (hipMemsetAsync((char*)d_ws + WS_CTL, 0, CTL_ZERO_BYTES, stream) != hipSuccess) return;
    Args a{};
    for (int i = 0; i < 20; ++i) a.in[i] = (const float*)d_in[i];
    a.out = (float*)d_out; a.ws = (unsigned char*)d_ws;
#if PROBE_STEP >= 0
    { int cuts[16]; int nc = 0; cuts[nc++] = 0;
      if (PROBE_STEP == 100) { cuts[nc++] = 1; } else { for (int l = 0; l < DEPTH; ++l) cuts[nc++] = 1 + 7 * l + PROBE_STEP + 1; }
      cuts[nc++] = NSTEP;
      for (int i = 0; i + 1 < nc; ++i) {
          a.s_lo = cuts[i]; a.s_hi = cuts[i + 1]; a.li = i; hipLaunchKernelGGL(mk_fwd, dim3(grid), dim3(NWAVES * 64), LDS_BYTES, stream, a);
          if (i + 2 < nc) { a.s_lo = cuts[i + 1] - 1; a.s_hi = cuts[i + 1]; a.opt = PROBE_OPT; hipLaunchKernelGGL(mk_fwd, dim3(grid), dim3(NWAVES * 64), LDS_BYTES, stream, a); a.opt = 0; }
      } }
#elif MK_ONE_LAUNCH
    a.s_lo = 0; a.s_hi = NSTEP;
    hipLaunchKernelGGL(mk_fwd, dim3(grid), dim3(NWAVES * 64), LDS_BYTES, stream, a);
#else
    for (int s = 0; s < NSTEP; ++s) { a.s_lo = s; a.s_hi = s + 1; hipLaunchKernelGGL(mk_fwd, dim3(grid), dim3(NWAVES * 64), LDS_BYTES, stream, a); }
#endif
}
```

```cpp
#include <hip/hip_runtime.h>
#include <cstdio>
#include <cstdint>

#ifndef ATTN_NAIVE
#define ATTN_NAIVE 0
#endif
#ifndef POOL_NAIVE
#define POOL_NAIVE 0
#endif
#ifndef PROBE_STEP
#define PROBE_STEP -1
#endif
#ifndef PROBE_OPT
#define PROBE_OPT 0
#endif
#ifndef MOE_FP8
#define MOE_FP8 1
#endif
#ifndef ROUTER_VALU
#define ROUTER_VALU 0
#endif
#ifndef MK_ONE_LAUNCH
#define MK_ONE_LAUNCH 1
#endif

#define GAS __attribute__((address_space(1)))
#define LAS __attribute__((address_space(3)))
typedef unsigned short bf16;
typedef unsigned u32x4 __attribute__((ext_vector_type(4)));
typedef unsigned u32x2 __attribute__((ext_vector_type(2)));
typedef float f32x4 __attribute__((ext_vector_type(4)));
typedef float f32x2 __attribute__((ext_vector_type(2)));
typedef short bf16x8 __attribute__((ext_vector_type(8)));
typedef GAS unsigned gu32;

constexpr int NB = 4, SEQ = 4096, D = 1024, M = NB * SEQ, DEPTH = 4;
constexpr int CHUNK = 64, NCH = SEQ / CHUNK, LEFTC = 8;
constexpr int NH = 8, HD = 64, AW = 512, PGRP = 128, INW = 2048;
constexpr int NE = 32, TOPK = 4, FE = 1024;
constexpr int MAXT = 288;
constexpr int MAXU = 9;
constexpr float EPS = 1e-6f;
constexpr float LOG2E = 1.4426950408889634f;
constexpr int MODW = 6 * D;

constexpr size_t MiB = 1u << 20;
constexpr size_t WS_CTL = 0, CTL_ZERO_BYTES = 1 * MiB;
constexpr size_t WS_MOD = 1 * MiB;
constexpr size_t WS_RWT = 2 * MiB;
constexpr size_t WS_GATE = 3 * MiB;
constexpr size_t WS_SLOT = 3 * MiB + 512 * 1024;
constexpr size_t WS_TOK = 4 * MiB;
constexpr size_t WS_PWT = 6 * MiB;
constexpr size_t WS_WIN = 8 * MiB;
constexpr size_t WS_WOUT = 24 * MiB;
constexpr size_t WS_XN = 32 * MiB;
constexpr size_t WS_QKVU = 64 * MiB;
constexpr size_t WS_MIX = 128 * MiB;
constexpr size_t WS_H = 160 * MiB;
constexpr size_t WS_OB = 304 * MiB;
constexpr size_t WS_W1 = 448 * MiB;
constexpr size_t WS_W2 = 960 * MiB;
constexpr size_t WS_XN8 = 1216 * MiB;
constexpr size_t WS_END = 1232 * MiB;
constexpr int CW_TMO = 0, CW_CODE = 1;
constexpr int CW_BAR = 4096, BAR_STRIDE = 4096;
constexpr int CW_CNT = 131072;

constexpr int RING_OFF = 0, RING_BYTES = 131072;
constexpr int LDSCTL_OFF = RING_BYTES;
constexpr int XTR_OFF = RING_BYTES + 512;
constexpr int LDS_BYTES = 147456;
constexpr int XTR_BYTES = LDS_BYTES - XTR_OFF;

#define RLX_AGENT __ATOMIC_RELAXED, __HIP_MEMORY_SCOPE_AGENT
#define LDS_WAIT() asm volatile("s_waitcnt lgkmcnt(0)" ::: "memory")
#define VM_WAIT() asm volatile("s_waitcnt vmcnt(0)" ::: "memory")
__device__ __forceinline__ unsigned f2bf(float f) { unsigned u = __builtin_bit_cast(unsigned, f); return (u + 0x7fffu + ((u >> 16) & 1u)) >> 16; }
__device__ __forceinline__ unsigned pk2(float lo, float hi) { return f2bf(lo) | (f2bf(hi) << 16); }
__device__ __forceinline__ unsigned cvt_pk_bf16(float lo, float hi) { unsigned r; asm volatile("v_cvt_pk_bf16_f32 %0, %1, %2" : "=v"(r) : "v"(lo), "v"(hi)); return r; }
__device__ __forceinline__ unsigned pk4_fp8(float a, float b, float c, float d) { int w = __builtin_amdgcn_cvt_pk_fp8_f32(a, b, 0, false); w = __builtin_amdgcn_cvt_pk_fp8_f32(c, d, w, true); return (unsigned)w; }
constexpr float FP8_ACT_SCALE = 4.0f, FP8_W_SCALE = 64.0f;
constexpr int FP8_ACT_E8M0 = 0x7d7d7d7d, FP8_W_E8M0 = 0x79797979;
__device__ __forceinline__ float bflo(unsigned u) { return __builtin_bit_cast(float, u << 16); }
__device__ __forceinline__ float bfhi(unsigned u) { return __builtin_bit_cast(float, u & 0xffff0000u); }
__device__ __forceinline__ float wave_sum(float v) {
#pragma unroll
    for (int o = 1; o < 64; o <<= 1) v += __shfl_xor(v, o);
    return v;
}

#define XB_TMO      128
#define XB_XCNT(j)  (256  + 64 * (j))
#define XB_XSUB(j)  (1280 + 64 * (j))
#define XB_XGEN(j)  (2304 + 64 * (j))
#define XB_TOP      3328
#define XB_TOPGEN   3392
#define XCD_BAR_WORDS 3456
#define XB_SPIN_CAP (1u << 18)
__device__ __forceinline__ unsigned xb_ld(unsigned* p)              { return __hip_atomic_load(p, __ATOMIC_RELAXED, __HIP_MEMORY_SCOPE_AGENT); }
__device__ __forceinline__ unsigned xb_add(unsigned* p, unsigned v) { return __hip_atomic_fetch_add(p, v, __ATOMIC_RELAXED, __HIP_MEMORY_SCOPE_AGENT); }
__device__ __forceinline__ unsigned xb_xcc_id() { return (unsigned)__builtin_amdgcn_s_getreg((3 << 11) | 20) & 0xFu; }
#define XB_SPIN(cond, bar) do { unsigned _sp = 0; while (cond) { __builtin_amdgcn_s_sleep(1); \
    if ((++_sp & 255u) == 0u) { if (xb_ld(&(bar)[XB_TMO])) break; if (_sp > XB_SPIN_CAP) { atomicAdd(&(bar)[XB_TMO], 1u); break; } } } } while (0)
struct XcdBarrier { unsigned* bar; unsigned x; volatile LAS unsigned* st; };
__device__ __forceinline__ XcdBarrier xcd_barrier_post(unsigned* bar, volatile LAS unsigned* st) {
    XcdBarrier b; b.bar = bar; b.x = xb_xcc_id(); b.st = st;
    if (threadIdx.x == 0) (void)xb_add(&bar[XB_XCNT(b.x)], 1u);
    return b;
}
__device__ __forceinline__ void xcd_barrier_complete(unsigned* bar, unsigned x, unsigned& nloc, unsigned& nx) {
    const unsigned G = gridDim.x * gridDim.y * gridDim.z;
    unsigned sum, cnt, mine, sp = 0u;
    for (;;) {
        sum = 0u; cnt = 0u; mine = 0u;
#pragma unroll
        for (unsigned j = 0; j < 16; ++j) { const unsigned c = xb_ld(&bar[XB_XCNT(j)]); sum += c; cnt += (c > 0u) ? 1u : 0u; mine = (j == x) ? c : mine; }
        if (sum == G) break;
        __builtin_amdgcn_s_sleep(1);
        if ((++sp & 255u) == 0u) { if (xb_ld(&bar[XB_TMO])) break; if (sp > XB_SPIN_CAP) { atomicAdd(&bar[XB_TMO], 1u); break; } }
    }
    nloc = mine > 0u ? mine : 1u; nx = cnt > 0u ? cnt : 1u;
}
__device__ __forceinline__ void xcd_barrier(const XcdBarrier& b) {
    asm volatile("s_waitcnt vmcnt(0)" ::: "memory");
    __syncthreads();
    if (threadIdx.x == 0) {
        unsigned* bar = b.bar;
        __builtin_amdgcn_s_waitcnt(0);
        unsigned nloc = b.st[0], nx = b.st[1];
        if (nloc == 0u) { xcd_barrier_complete(bar, b.x, nloc, nx); b.st[0] = nloc; b.st[1] = nx; }
        const unsigned old = xb_add(&bar[XB_XSUB(b.x)], 1u);
        const unsigned gen = old / nloc;
        if (old + 1u == (gen + 1u) * nloc) {
            __builtin_amdgcn_fence(__ATOMIC_RELEASE, "agent");
            asm volatile("s_waitcnt vmcnt(0)" ::: "memory");
            const unsigned og = xb_add(&bar[XB_TOP], 1u);
            const unsigned tg = og / nx;
            if (og + 1u == (tg + 1u) * nx) xb_add(&bar[XB_TOPGEN], 1u);
            else XB_SPIN(xb_ld(&bar[XB_TOPGEN]) == tg, bar);
            __builtin_amdgcn_fence(__ATOMIC_ACQUIRE, "agent");
            xb_add(&bar[XB_XGEN(b.x)], 1u);
            asm volatile("s_waitcnt vmcnt(0)" ::: "memory");
        } else {
            XB_SPIN(xb_ld(&bar[XB_XGEN(b.x)]) == gen, bar);
            __builtin_amdgcn_fence(__ATOMIC_ACQUIRE, "agent");
            asm volatile("s_waitcnt vmcnt(0)" ::: "memory");
        }
    }
    __syncthreads();
}

namespace pg8 {
constexpr int BM = 256, BK = 64, HALF = 128, HTB = HALF * BK * 2, STAGE_BYTES = 8 * HTB, NXCD = 8, WGM = 8, KD = 1024;
constexpr size_t KSTEP = (size_t)BK * 2, HSTEP = (size_t)HALF * KD * 2, TSTEP = 2 * HSTEP;
__host__ __device__ __forceinline__ int lds_byte(int r, int c) { const int st = (r >> 4) * 2 + (c >> 5), rr = r & 15, cc = c & 31, ob = rr * 64 + cc * 2; return st * 1024 + (ob ^ (((ob >> 9) & 1) << 5)); }
__host__ __device__ __forceinline__ void stage_rc(int b, int& R, int& C) { const int st = b / 1024, sb = b % 1024, swz = sb ^ (((sb >> 9) & 1) << 5); R = (st >> 1) * 16 + swz / 64; C = (st & 1) * 32 + (swz % 64) / 2; }
__host__ __device__ __forceinline__ int perm32(int rho) { const int n = rho >> 4, i = rho & 15; return 8 * (i >> 2) + 4 * n + (i & 3); }

struct GUnit { const char* A; const char* B; int row0; int pn; int e; int li; };

struct DenseOrder {
    int nM, nN, nwg, G, c; const char* A; const char* B;
    __device__ __forceinline__ void init(int M_, int N_, int G_, int c_, const void* A_, const void* B_) { nM = M_ / BM; nN = N_ / BM; nwg = nM * nN; G = G_; c = c_; A = (const char*)A_; B = (const char*)B_; }
    __device__ __forceinline__ bool next(int i, GUnit& u) const {
        const long L = (long)i * G + c; if (L >= nwg) return false;
        int wgid = (int)L; { const int q = nwg / NXCD, r = nwg % NXCD, xcd = wgid % NXCD, off = wgid / NXCD; wgid = (xcd < r ? xcd * (q + 1) : r * (q + 1) + (xcd - r) * q) + off; }
        const int nig = WGM * nN, gid = wgid / nig, fm = gid * WGM, gsz = (nM - fm) < WGM ? (nM - fm) : WGM;
        const int pm = fm + ((wgid % nig) % gsz), pn = (wgid % nig) / gsz;
        u.A = A; u.B = B + (size_t)pn * TSTEP; u.row0 = pm * BM; u.pn = pn; u.e = 0; u.li = i; return true;
    }
    __device__ __forceinline__ unsigned rowoff(const GUnit& u, int r) const { return (unsigned)(u.row0 + r) * (unsigned)(KD * 2); }
};
template <bool TOK, int EBY>
struct MoeOrder {
    const LAS int* tile_e; const LAS unsigned* toff;
    int T, vcu, G, ncol, rpb; const char* A; const char* B; size_t estride, tstep;
    __device__ __forceinline__ bool next(int i, GUnit& u) const {
        const int uu = vcu + i * G; if (uu >= T * ncol) return false;
        const int blk = uu >> 5, j = uu & 31; int tib = T - blk * rpb; tib = tib > rpb ? rpb : tib;
        const int tile = blk * rpb + j % tib, pn = j / tib;
        const int e = __builtin_amdgcn_readfirstlane(tile_e[tile]);
        u.row0 = tile * BM; u.pn = pn; u.e = e; u.li = i;
        u.A = A; u.B = B + (size_t)e * estride + (size_t)pn * tstep; return true;
    }
    __device__ __forceinline__ unsigned rowoff(const GUnit& u, int r) const { if constexpr (TOK) return toff[u.li * 256 + r]; else return (unsigned)(u.row0 + r) * (unsigned)(KD * EBY); }
};

typedef f32x4 Acc[2][2][4][2];
typedef int i32x4 __attribute__((ext_vector_type(4)));
typedef int i32x8 __attribute__((ext_vector_type(8)));

struct EpiWin {
    static constexpr bool PERM = true;
    bf16* O; const float* qg; const float* kg;
    __device__ __forceinline__ void operator()(const Acc& acc, const GUnit& u, int wr, int wc, int fr, int fq) const {
        asm volatile("" : "+v"(fr), "+v"(fq));
        const int kind = u.pn >> 1;
        const int col0 = u.pn * 256 + 64 * wc + 8 * fq;
        f32x4 gv[2][2];
#pragma unroll
        for (int bj = 0; bj < 2; ++bj)
#pragma unroll
            for (int n = 0; n < 2; ++n) {
                const int d = 32 * bj + 8 * fq + 4 * n;
                if (kind == 0) gv[bj][n] = *(const f32x4*)(qg + d) * (0.125f * LOG2E);
                else if (kind == 1) gv[bj][n] = *(const f32x4*)(kg + d);
                else gv[bj][n] = (f32x4){1.f, 1.f, 1.f, 1.f};
            }
#pragma unroll
        for (int ai = 0; ai < 2; ++ai)
#pragma unroll
            for (int m = 0; m < 4; ++m) {
                const int row = u.row0 + ai * HALF + wr * 64 + m * 16 + fr;
                float rstd = 1.f;
                if (kind < 2) {
                    float ss = 0.f;
#pragma unroll
                    for (int bj = 0; bj < 2; ++bj)
#pragma unroll
                        for (int n = 0; n < 2; ++n) { const f32x4 x = acc[ai][bj][m][n]; ss += (x[0] * x[0] + x[1] * x[1]) + (x[2] * x[2] + x[3] * x[3]); }
                    ss += __shfl_xor(ss, 16); ss += __shfl_xor(ss, 32);
                    rstd = __builtin_amdgcn_rsqf(ss * (1.f / 64.f) + EPS);
                }
                bf16* rowp = O + (size_t)row * INW + col0;
#pragma unroll
                for (int bj = 0; bj < 2; ++bj) {
                    const f32x4 v0 = acc[ai][bj][m][0] * rstd * gv[bj][0], v1 = acc[ai][bj][m][1] * rstd * gv[bj][1];
                    u32x4 w; w.x = cvt_pk_bf16(v0[0], v0[1]); w.y = cvt_pk_bf16(v0[2], v0[3]); w.z = cvt_pk_bf16(v1[0], v1[1]); w.w = cvt_pk_bf16(v1[2], v1[3]);
                    *(u32x4*)(rowp + 32 * bj) = w;
                }
            }
    }
};
struct EpiWout {
    static constexpr bool PERM = false;
    const float* xin; float* xout; const float* g1;
    __device__ __forceinline__ void operator()(const Acc& acc, const GUnit& u, int wr, int wc, int fr, int fq) const {
        asm volatile("" : "+v"(fr), "+v"(fq));
        const int b = u.row0 / SEQ; const int col0 = u.pn * BM + wc * 32 + 4 * fq;
        f32x4 gv[2][2];
#pragma unroll
        for (int bj = 0; bj < 2; ++bj)
#pragma unroll
            for (int n = 0; n < 2; ++n) gv[bj][n] = *(const f32x4*)(g1 + (size_t)b * MODW + col0 + bj * HALF + n * 16);
#pragma unroll
        for (int ai = 0; ai < 2; ++ai)
#pragma unroll
            for (int m = 0; m < 4; ++m) {
                const size_t off = (size_t)(u.row0 + ai * HALF + wr * 64 + m * 16 + fr) * D + col0;
#pragma unroll
                for (int bj = 0; bj < 2; ++bj)
#pragma unroll
                    for (int n = 0; n < 2; ++n) { const f32x4 xv = *(const f32x4*)(xin + off + bj * HALF + n * 16); *(f32x4*)(xout + off + bj * HALF + n * 16) = xv + gv[bj][n] * acc[ai][bj][m][n]; }
                if (m & 1) asm volatile("" ::: "memory");
            }
    }
};
struct EpiSwiglu {
    static constexpr bool PERM = true;
    bf16* H; const float* b1;
    __device__ __forceinline__ void operator()(const Acc& acc, const GUnit& u, int wr, int wc, int fr, int fq) const {
        asm volatile("" : "+v"(fr), "+v"(fq));
        const int j0 = u.pn * 128 + wc * 32 + 8 * fq; const float* be = b1 + (size_t)u.e * 2048 + j0;
        f32x4 bg[2], bl[2];
#pragma unroll
        for (int n = 0; n < 2; ++n) { bg[n] = *(const f32x4*)(be + 4 * n); bl[n] = *(const f32x4*)(be + 1024 + 4 * n); }
#pragma unroll
        for (int ai = 0; ai < 2; ++ai)
#pragma unroll
            for (int m = 0; m < 4; ++m) {
                bf16* rowp = H + (size_t)(u.row0 + ai * HALF + wr * 64 + m * 16 + fr) * FE + j0;
                float o[8];
#pragma unroll
                for (int n = 0; n < 2; ++n)
#pragma unroll
                    for (int i = 0; i < 4; ++i) {
                        float g = acc[ai][0][m][n][i] + bg[n][i], l = acc[ai][1][m][n][i] + bl[n][i];
                        g = fminf(g, 7.0f); l = fminf(fmaxf(l, -7.0f), 7.0f);
                        const float sg = __builtin_amdgcn_rcpf(1.0f + __builtin_amdgcn_exp2f(-1.702f * LOG2E * g));
                        o[4 * n + i] = g * sg * (l + 1.0f);
                    }
#if MOE_FP8
                u32x2 w; w.x = pk4_fp8(o[0] * FP8_ACT_SCALE, o[1] * FP8_ACT_SCALE, o[2] * FP8_ACT_SCALE, o[3] * FP8_ACT_SCALE); w.y = pk4_fp8(o[4] * FP8_ACT_SCALE, o[5] * FP8_ACT_SCALE, o[6] * FP8_ACT_SCALE, o[7] * FP8_ACT_SCALE);
                *(u32x2*)((unsigned char*)H + (size_t)(u.row0 + ai * HALF + wr * 64 + m * 16 + fr) * FE + j0) = w;
#else
                u32x4 w; w.x = cvt_pk_bf16(o[0], o[1]); w.y = cvt_pk_bf16(o[2], o[3]); w.z = cvt_pk_bf16(o[4], o[5]); w.w = cvt_pk_bf16(o[6], o[7]);
                *(u32x4*)rowp = w;
#endif
            }
    }
};
struct EpiOB {
    static constexpr bool PERM = true;
    bf16* O; const float* b2;
    __device__ __forceinline__ void operator()(const Acc& acc, const GUnit& u, int wr, int wc, int fr, int fq) const {
        asm volatile("" : "+v"(fr), "+v"(fq));
        const int col0 = u.pn * BM + wc * 32 + 8 * fq; const float* be = b2 + (size_t)u.e * D + col0;
        f32x4 bv[2][2];
#pragma unroll
        for (int bj = 0; bj < 2; ++bj)
#pragma unroll
            for (int n = 0; n < 2; ++n) bv[bj][n] = *(const f32x4*)(be + bj * HALF + 4 * n);
#pragma unroll
        for (int ai = 0; ai < 2; ++ai)
#pragma unroll
            for (int m = 0; m < 4; ++m) {
                bf16* rowp = O + (size_t)(u.row0 + ai * HALF + wr * 64 + m * 16 + fr) * D + col0;
#pragma unroll
                for (int bj = 0; bj < 2; ++bj) {
                    const f32x4 v0 = acc[ai][bj][m][0] + bv[bj][0], v1 = acc[ai][bj][m][1] + bv[bj][1];
                    u32x4 w; w.x = cvt_pk_bf16(v0[0], v0[1]); w.y = cvt_pk_bf16(v0[2], v0[3]); w.z = cvt_pk_bf16(v1[0], v1[1]); w.w = cvt_pk_bf16(v1[2], v1[3]);
                    *(u32x4*)(rowp + bj * HALF) = w;
                }
            }
    }
};

template <class Epi, class Sched, bool GATHER, int EB = 2  >
__device__ __forceinline__ void gemm_phase(LAS unsigned char* lds, const Sched& S, const Epi& E) {
    int tid_ = threadIdx.x; asm volatile("" : "+v"(tid_));
    const int tid = tid_, wid = __builtin_amdgcn_readfirstlane(tid >> 6), lane = tid & 63, wr = wid >> 2, wc = wid & 3, fr = lane & 15, fq = lane >> 4;
    constexpr int K = KD, KB = K * EB  , nt = KB / (BK * 2);
    unsigned voffA[2], voffB[2]; int RA[2]; unsigned CA[2];
#pragma unroll
    for (int i = 0; i < 2; ++i) { int R, C; stage_rc(tid * 16 + i * 8192, R, C); const int Rb = Epi::PERM ? ((R & ~31) + perm32(R & 31)) : R;
        voffA[i] = (unsigned)(R * KB + C * 2); voffB[i] = (unsigned)(Rb * KB + C * 2); RA[i] = R; CA[i] = (unsigned)C * 2u; }
    constexpr size_t kstep = KSTEP, hstep = (size_t)HALF * KB;
    const unsigned ldsw = (unsigned)wid * 1024u;
    const int aoff = lds_byte(wr * 64 + fr, fq * 8), boff = lds_byte(wc * 32 + fr, fq * 8);
#define PG8_SA(b, h) (((b) * 2 + (h)) * HTB)
#define PG8_SB(b, h) ((4 + (b) * 2 + (h)) * HTB)
#define PG8_STAGE(bufoff, gbase, voff) do { _Pragma("unroll") for (int _i = 0; _i < 2; ++_i) \
        __builtin_amdgcn_global_load_lds((const unsigned*)((const char*)(gbase) + (voff)[_i]), (LAS unsigned*)(lds + (bufoff) + ldsw + _i * 8192), 16, 0, 0); } while (0)
#define PG8_STAGE_A(bufoff, base, h, V) do { if constexpr (GATHER) { PG8_STAGE(bufoff, base, (V)[h]); } else { PG8_STAGE(bufoff, (base) + (h) * hstep, voffA); } } while (0)
#define PG8_LD32(p) __builtin_shufflevector(*(const LAS i32x4*)(p), *(const LAS i32x4*)((p) + 1024), 0, 1, 2, 3, 4, 5, 6, 7)
#define PG8_LDA(dst, b, h) do { _Pragma("unroll") for (int m = 0; m < 4; ++m) dst[m] = PG8_LD32(lds + PG8_SA(b, h) + aoff + m * 2048); } while (0)
#define PG8_LDB(dst, b, h) do { _Pragma("unroll") for (int n = 0; n < 2; ++n) dst[n] = PG8_LD32(lds + PG8_SB(b, h) + boff + n * 2048); } while (0)
#define PG8_MMA(ai, bj, At, Bt) do { __builtin_amdgcn_s_setprio(1); _Pragma("unroll") for (int m = 0; m < 4; ++m) _Pragma("unroll") for (int n = 0; n < 2; ++n) { \
        if constexpr (EB == 2) {   \
            acc[ai][bj][m][n] = __builtin_amdgcn_mfma_f32_16x16x32_bf16(__builtin_bit_cast(bf16x8, __builtin_shufflevector(Bt[n], Bt[n], 0, 1, 2, 3)), __builtin_bit_cast(bf16x8, __builtin_shufflevector(At[m], At[m], 0, 1, 2, 3)), acc[ai][bj][m][n], 0, 0, 0); \
            acc[ai][bj][m][n] = __builtin_amdgcn_mfma_f32_16x16x32_bf16(__builtin_bit_cast(bf16x8, __builtin_shufflevector(Bt[n], Bt[n], 4, 5, 6, 7)), __builtin_bit_cast(bf16x8, __builtin_shufflevector(At[m], At[m], 4, 5, 6, 7)), acc[ai][bj][m][n], 0, 0, 0); } \
        else {   \
            acc[ai][bj][m][n] = __builtin_amdgcn_mfma_scale_f32_16x16x128_f8f6f4(Bt[n], At[m], acc[ai][bj][m][n], 0, 0, 0, FP8_W_E8M0, 0, FP8_ACT_E8M0); } } \
        __builtin_amdgcn_s_setprio(0); } while (0)
#define PG8_WAIT_V(n) asm volatile("s_waitcnt vmcnt(" #n ")" ::: "memory")
#define PG8_WAIT_L(n) asm volatile("s_waitcnt lgkmcnt(" #n ")" ::: "memory")
#define PG8_BAR __builtin_amdgcn_s_barrier()
#define PG8_SCHED __builtin_amdgcn_sched_barrier(0)
#define PG8_AOFF(V, U) do { if constexpr (GATHER) { _Pragma("unroll") for (int _h = 0; _h < 2; ++_h) _Pragma("unroll") for (int _i = 0; _i < 2; ++_i) (V)[_h][_i] = S.rowoff((U), _h * HALF + RA[_i]) + CA[_i]; } } while (0)
    GUnit cur, nxt; int ui = 0;
    if (!S.next(0, cur)) return;
    Acc acc;
#pragma unroll
    for (int a = 0; a < 2; ++a)
#pragma unroll
        for (int b = 0; b < 2; ++b)
#pragma unroll
            for (int m = 0; m < 4; ++m)
#pragma unroll
                for (int n = 0; n < 2; ++n) acc[a][b][m][n] = (f32x4){0.f, 0.f, 0.f, 0.f};
    i32x8 At[4], B0[2], B1[2];
    unsigned va[2][2] = {{0u, 0u}, {0u, 0u}};
    const char* cA = cur.A; const char* cB = cur.B;
    PG8_AOFF(va, cur);
    PG8_STAGE(PG8_SB(0, 0), cB, voffB); PG8_STAGE(PG8_SB(0, 1), cB + hstep, voffB); PG8_STAGE_A(PG8_SA(0, 0), cA, 0, va); PG8_STAGE_A(PG8_SA(0, 1), cA, 1, va);
    if (wr == 1) PG8_BAR;
    PG8_WAIT_V(2); PG8_BAR;
    PG8_STAGE(PG8_SB(1, 0), cB + kstep, voffB); PG8_STAGE_A(PG8_SA(1, 0), cA + kstep, 0, va); PG8_STAGE(PG8_SB(1, 1), cB + hstep + kstep, voffB);
    PG8_WAIT_V(6); PG8_BAR;
    for (;;) {
        const bool has_next = S.next(ui + 1, nxt);
        const char* nA = has_next ? nxt.A : cA; const char* nB = has_next ? nxt.B : cB;
#pragma unroll 1
        for (int t = 0; t < nt; t += 2) {
            const bool last = (t == nt - 2);
            const char* a1 = cA + (size_t)(t + 1) * kstep;
            const char* a2 = last ? nA : cA + (size_t)(t + 2) * kstep; const char* b2 = last ? nB : cB + (size_t)(t + 2) * kstep;
            const char* a3 = a2 + kstep; const char* b3 = b2 + kstep;
            PG8_LDB(B0, 0, 0); PG8_LDB(B1, 0, 1); PG8_SCHED; PG8_LDA(At, 0, 0); PG8_STAGE_A(PG8_SA(1, 1), a1, 1, va);
            if constexpr (GATHER) { if (last && has_next) { PG8_AOFF(va, nxt); } }
            PG8_WAIT_V(8); PG8_WAIT_L(0); PG8_BAR; PG8_MMA(0, 0, At, B0); PG8_MMA(0, 1, At, B1); PG8_BAR; PG8_SCHED;
            PG8_LDA(At, 0, 1); PG8_STAGE(PG8_SB(0, 0), b2, voffB); PG8_STAGE(PG8_SB(0, 1), b2 + hstep, voffB); PG8_STAGE_A(PG8_SA(0, 0), a2, 0, va);
            PG8_WAIT_V(8); PG8_WAIT_L(0); PG8_BAR; PG8_MMA(1, 0, At, B0); PG8_MMA(1, 1, At, B1); PG8_BAR; PG8_SCHED;
            PG8_LDB(B0, 1, 0); PG8_LDB(B1, 1, 1); PG8_SCHED; PG8_LDA(At, 1, 0); PG8_STAGE_A(PG8_SA(0, 1), a2, 1, va);
            PG8_WAIT_V(8); PG8_WAIT_L(0); PG8_BAR; PG8_MMA(0, 0, At, B0); PG8_MMA(0, 1, At, B1); PG8_BAR; PG8_SCHED;
            PG8_LDA(At, 1, 1); PG8_STAGE(PG8_SB(1, 0), b3, voffB); PG8_STAGE(PG8_SB(1, 1), b3 + hstep, voffB); PG8_STAGE_A(PG8_SA(1, 0), a3, 0, va);
            PG8_WAIT_V(8); PG8_WAIT_L(0); PG8_BAR; PG8_MMA(1, 0, At, B0); PG8_MMA(1, 1, At, B1); PG8_BAR; PG8_SCHED;
        }
        if (wr == 0) PG8_BAR;
        E(acc, cur, wr, wc, fr, fq);
        if (!has_next) break;
#pragma unroll
        for (int a = 0; a < 2; ++a)
#pragma unroll
            for (int b = 0; b < 2; ++b)
#pragma unroll
                for (int m = 0; m < 4; ++m)
#pragma unroll
                    for (int n = 0; n < 2; ++n) acc[a][b][m][n] = (f32x4){0.f, 0.f, 0.f, 0.f};
        cur = nxt; cA = nA; cB = nB; ++ui;
        if (wr == 1) PG8_BAR;
    }
    PG8_WAIT_V(0);
    PG8_BAR;
#undef PG8_SA
#undef PG8_SB
#undef PG8_STAGE
#undef PG8_STAGE_A
#undef PG8_LDA
#undef PG8_LDB
#undef PG8_MMA
#undef PG8_WAIT_V
#undef PG8_WAIT_L
#undef PG8_BAR
#undef PG8_SCHED
#undef PG8_AOFF
}
}

struct Args { const float* in[20]; float* out; unsigned char* ws; int s_lo, s_hi, li, opt; };
#define P_x (A.in[0])
#define P_c (A.in[1])
#define P_norm1_g (A.in[2])
#define P_w_mod (A.in[3])
#define P_b_mod (A.in[4])
#define P_w_in (A.in[5])
#define P_q_g (A.in[6])
#define P_k_g (A.in[7])
#define P_rel_bias (A.in[8])
#define P_pool_w (A.in[9])
#define P_pool_b (A.in[10])
#define P_pool_scale (A.in[11])
#define P_w_out (A.in[12])
#define P_norm2_g (A.in[13])
#define P_router_w (A.in[14])
#define P_router_b (A.in[15])
#define P_exp_w1 (A.in[16])
#define P_exp_b1 (A.in[17])
#define P_exp_w2 (A.in[18])
#define P_exp_b2 (A.in[19])
#define P_out (A.out)
#define P_PWT ((bf16*)(A.ws + WS_PWT))
#define P_XN8 ((unsigned char*)(A.ws + WS_XN8))
#define P_RWH ((bf16*)(A.ws + WS_RWT + 512 * 1024))
#define P_RWL ((bf16*)(A.ws + WS_RWT + 768 * 1024))
#define P_H8 ((unsigned char*)(A.ws + WS_H))
#define P_W18 ((unsigned char*)(A.ws + WS_W1))
#define P_W28 ((unsigned char*)(A.ws + WS_W2))
#define P_mod ((float*)(A.ws + WS_MOD))
#define P_rwT ((float*)(A.ws + WS_RWT))
#define P_gate ((float*)(A.ws + WS_GATE))
#define P_slot ((int*)(A.ws + WS_SLOT))
#define P_tok ((int*)(A.ws + WS_TOK))
#define P_WIN ((bf16*)(A.ws + WS_WIN))
#define P_WOUT ((bf16*)(A.ws + WS_WOUT))
#define P_XN ((bf16*)(A.ws + WS_XN))
#define P_QKVU ((bf16*)(A.ws + WS_QKVU))
#define P_MIX ((bf16*)(A.ws + WS_MIX))
#define P_H ((bf16*)(A.ws + WS_H))
#define P_OB ((bf16*)(A.ws + WS_OB))
#define P_W1 ((bf16*)(A.ws + WS_W1))
#define P_W2 ((bf16*)(A.ws + WS_W2))
constexpr int NWAVES = 8;
struct Frame {
    LAS unsigned char* lds;
    volatile LAS unsigned* MISC;
    gu32* ctl;
    int tid, lane, wave, vcu, G;
};

__device__ __forceinline__ void p0_mod(Frame& F, const Args& A) {
    LAS float* cond = (LAS float*)(F.lds);
    LAS float* red = (LAS float*)(F.lds + 16384);
    for (int i = F.tid; i < NB * D; i += NWAVES * 64) { const float cv = P_c[i]; cond[i] = cv / (1.f + __expf(-cv)); }
    __syncthreads();
    const int c4 = F.lane & 31, rs = F.lane >> 5;
    for (int it = F.vcu; it < DEPTH * (MODW / 128); it += F.G) {
        const int l = it / (MODW / 128), cb = it % (MODW / 128);
        f32x4 acc[4];
#pragma unroll
        for (int b = 0; b < 4; ++b) acc[b] = (f32x4){0.f, 0.f, 0.f, 0.f};
        const float* wp = P_w_mod + ((size_t)l * D + 128 * F.wave + rs) * MODW + 128 * cb + 4 * c4;
#pragma unroll 8
        for (int kk = 0; kk < 64; ++kk) {
            const f32x4 wv = *(const f32x4*)(wp + (size_t)(2 * kk) * MODW);
            const int k = 128 * F.wave + 2 * kk + rs;
#pragma unroll
            for (int b = 0; b < 4; ++b) acc[b] += cond[b * D + k] * wv;
        }
#pragma unroll
        for (int b = 0; b < 4; ++b)
#pragma unroll
            for (int i = 0; i < 4; ++i) acc[b][i] += __shfl_xor(acc[b][i], 32);
        if (rs == 0) {
#pragma unroll
            for (int b = 0; b < 4; ++b) *(LAS f32x4*)(red + (F.wave * 4 + b) * 128 + 4 * c4) = acc[b];
        }
        __syncthreads();
        { const int b = F.tid >> 7, col = F.tid & 127; float s = 0.f;
#pragma unroll
          for (int w = 0; w < 8; ++w) s += red[(w * 4 + b) * 128 + col];
          P_mod[((size_t)l * NB + b) * MODW + 128 * cb + col] = s + P_b_mod[(size_t)l * MODW + 128 * cb + col]; }
        __syncthreads();
    }
    __syncthreads();
}
struct TrDesc { const float* src; bf16* dst; int N, pitch; bool f8; };
__device__ __forceinline__ TrDesc tr_decode(const Args& A, int it) {
    constexpr int I_IN = DEPTH * 16 * 64, I_OUT = DEPTH * 16 * 32, I_W1 = DEPTH * NE * 16 * 64, I_W2 = DEPTH * NE * 16 * 32;
    TrDesc d; int r = it;
    if (r < I_W1) { const int le = r >> 10, rr = r & 1023, kb = rr >> 6, nb = rr & 63, n0 = 32 * nb, bj = n0 >> 10, jj = n0 & 1023, drow = 256 * (jj >> 7) + 128 * bj + (jj & 127);
        d.src = P_exp_w1 + (size_t)le * D * 2048 + (size_t)(64 * kb) * 2048 + n0; d.N = 2048; d.pitch = 1024;
#if MOE_FP8
        d.dst = (bf16*)(P_W18 + (size_t)le * 2048 * D + (size_t)drow * 1024 + 64 * kb); d.f8 = true;
#else
        d.dst = P_W1 + (size_t)le * 2048 * D + (size_t)drow * 1024 + 64 * kb; d.f8 = false;
#endif
        return d; }
    r -= I_W1;
    if (r < I_W2) { const int le = r >> 9, rr = r & 511, kb = rr >> 5, nb = rr & 31;
        d.src = P_exp_w2 + (size_t)le * FE * D + (size_t)(64 * kb) * D + 32 * nb; d.N = D; d.pitch = 1024;
#if MOE_FP8
        d.dst = (bf16*)(P_W28 + (size_t)le * D * FE + (size_t)(32 * nb) * 1024 + 64 * kb); d.f8 = true;
#else
        d.dst = P_W2 + (size_t)le * D * FE + (size_t)(32 * nb) * 1024 + 64 * kb; d.f8 = false;
#endif
        return d; }
    r -= I_W2;
    if (r < I_IN) { const int l = r >> 10, rr = r & 1023, kb = rr >> 6, nb = rr & 63, n0 = 32 * nb, g = (n0 & 255) >> 5, drow = (n0 & ~255) + 128 * (g & 1) + 32 * (g >> 1);
        d.src = P_w_in + (size_t)l * D * INW + (size_t)(64 * kb) * INW + n0; d.dst = P_WIN + (size_t)l * INW * D + (size_t)drow * 1024 + 64 * kb; d.N = INW; d.pitch = 1024; d.f8 = false; return d; }
    r -= I_IN;
    if (r < I_OUT) { const int l = r >> 9, rr = r & 511, kb = rr >> 5, nb = rr & 31;
        d.src = P_w_out + (size_t)l * D * D + (size_t)(64 * kb) * D + 32 * nb; d.dst = P_WOUT + (size_t)l * D * D + (size_t)(32 * nb) * 1024 + 64 * kb; d.N = D; d.pitch = 1024; d.f8 = false; return d; }
    r -= I_OUT;
    { const int m = r >> 3, rr = r & 7, kb = rr >> 2, nb = rr & 3;
        d.src = P_pool_w + (size_t)m * PGRP * PGRP + (size_t)(64 * kb) * PGRP + 32 * nb; d.dst = P_PWT + (size_t)m * PGRP * PGRP + (size_t)(32 * nb) * PGRP + 64 * kb; d.N = PGRP; d.pitch = PGRP; d.f8 = false; return d; }
}
__device__ __forceinline__ void p0_convert(Frame& F, const Args& A) {
    LAS float* scr = (LAS float*)(F.lds + RING_OFF + F.wave * 16384);
    const int gw = F.vcu * NWAVES + F.wave, NGW = F.G * NWAVES, lane = F.lane;
    constexpr int NIT = DEPTH * 16 * 64 + DEPTH * 16 * 32 + DEPTH * NE * 16 * 64 + DEPTH * NE * 16 * 32 + DEPTH * 4 * 8;
    float cv[32];
    TrDesc cur = tr_decode(A, gw < NIT ? gw : 0);
    { const float* sp = cur.src + (size_t)(lane >> 5) * cur.N + (lane & 31);
#pragma unroll
      for (int i = 0; i < 32; ++i) cv[i] = sp[(size_t)(2 * i) * cur.N]; }
    for (int it = gw; it < NIT; it += NGW) {
        const int nit = it + NGW; const bool hn = nit < NIT;
        TrDesc nd = tr_decode(A, hn ? nit : it);
        float nv[32];
        { const float* sp = nd.src + (size_t)(lane >> 5) * nd.N + (lane & 31);
#pragma unroll
          for (int i = 0; i < 32; ++i) nv[i] = sp[(size_t)(2 * i) * nd.N]; }
#pragma unroll
        for (int i = 0; i < 32; ++i) scr[(2 * i + (lane >> 5)) * 33 + (lane & 31)] = cv[i];
        LDS_WAIT(); asm volatile("" ::: "memory");
        if (cur.f8) {
            const int n = lane & 31, hf = lane >> 5; const LAS float* s = scr + (32 * hf) * 33 + n; unsigned char* dp = (unsigned char*)cur.dst + (size_t)n * 1024 + 32 * hf;
#pragma unroll
            for (int q = 0; q < 2; ++q) { u32x4 o;
                o.x = pk4_fp8(s[(16 * q + 0) * 33] * FP8_W_SCALE, s[(16 * q + 1) * 33] * FP8_W_SCALE, s[(16 * q + 2) * 33] * FP8_W_SCALE, s[(16 * q + 3) * 33] * FP8_W_SCALE);
                o.y = pk4_fp8(s[(16 * q + 4) * 33] * FP8_W_SCALE, s[(16 * q + 5) * 33] * FP8_W_SCALE, s[(16 * q + 6) * 33] * FP8_W_SCALE, s[(16 * q + 7) * 33] * FP8_W_SCALE);
                o.z = pk4_fp8(s[(16 * q + 8) * 33] * FP8_W_SCALE, s[(16 * q + 9) * 33] * FP8_W_SCALE, s[(16 * q + 10) * 33] * FP8_W_SCALE, s[(16 * q + 11) * 33] * FP8_W_SCALE);
                o.w = pk4_fp8(s[(16 * q + 12) * 33] * FP8_W_SCALE, s[(16 * q + 13) * 33] * FP8_W_SCALE, s[(16 * q + 14) * 33] * FP8_W_SCALE, s[(16 * q + 15) * 33] * FP8_W_SCALE);
                *(GAS u32x4*)(dp + 16 * q) = o; }
        } else { const int c = lane & 7;
#pragma unroll
          for (int j = 0; j < 4; ++j) { const int n = (lane >> 3) + 8 * j; const LAS float* s = scr + (8 * c) * 33 + n;
            u32x4 o; o.x = pk2(s[0 * 33], s[1 * 33]); o.y = pk2(s[2 * 33], s[3 * 33]); o.z = pk2(s[4 * 33], s[5 * 33]); o.w = pk2(s[6 * 33], s[7 * 33]);
            *(GAS u32x4*)(cur.dst + (size_t)n * cur.pitch + 8 * c) = o; } }
        LDS_WAIT(); asm volatile("" ::: "memory");
        cur = nd;
#pragma unroll
        for (int i = 0; i < 32; ++i) cv[i] = nv[i];
    }
    for (int i = (F.vcu * NWAVES * 64 + F.tid); i < DEPTH * NE * D; i += F.G * NWAVES * 64) { const int l = i >> 15, e = (i >> 10) & 31, cc = i & 1023; const float w = P_router_w[((size_t)l * D + cc) * NE + e]; P_rwT[i] = w; const unsigned hb = f2bf(w); P_RWH[i] = (bf16)hb; P_RWL[i] = (bf16)f2bf(w - __builtin_bit_cast(float, hb << 16)); }
}

__device__ __forceinline__ int moe_tables(Frame& F, int l) {
    LAS int* X = (LAS int*)(F.lds + XTR_OFF);
    __syncthreads();
    if (F.tid < NE) X[F.tid] = (int)__hip_atomic_load(F.ctl + CW_CNT + (32 * l + F.tid) * 64, RLX_AGENT);
    __syncthreads();
    if (F.tid == 0) { int t = 0; for (int e = 0; e < NE; ++e) { X[32 + e] = t; t += (X[e] + 255) >> 8; } X[32 + NE] = t; X[66] = t; }
    __syncthreads();
    if (F.tid < NE) { const int t0 = X[32 + F.tid], t1 = X[33 + F.tid]; for (int t = t0; t < t1; ++t) X[128 + t] = F.tid; }
    __syncthreads();
    return X[66];
}

template <bool COMBINE, bool NORM>
__device__ __forceinline__ void phase_cn(Frame& F, const Args& A, int l) {
    LAS int* X = (LAS int*)(F.lds + XTR_OFF);
    if (COMBINE) (void)moe_tables(F, l - 1);
    const float* xin = (COMBINE || l > 0) ? P_out : P_x;
    const bool probe = (A.opt & 4) != 0;
    float* xout = probe ? (float*)(A.ws + WS_H) : P_out; bf16* xnout = probe ? (bf16*)(A.ws + WS_H + 64 * MiB) : P_XN;
    for (int rb = F.vcu * NWAVES + F.wave; rb < M / 8; rb += F.G * NWAVES) {
        const int row0 = rb * 8, b = row0 / SEQ;
        f32x4 a[4], s[4], g2v[4];
#pragma unroll
        for (int j = 0; j < 4; ++j) {
            const int c = 4 * F.lane + 256 * j;
            if (NORM) { const f32x4 g = *(const f32x4*)(P_norm1_g + (size_t)l * D + c); const float* mp = P_mod + ((size_t)l * NB + b) * MODW;
                a[j] = g * (*(const f32x4*)(mp + D + c) + 1.0f); s[j] = *(const f32x4*)(mp + c); }
            if (COMBINE) g2v[j] = *(const f32x4*)(P_mod + ((size_t)(l - 1) * NB + b) * MODW + 5 * D + c);
        }
        int orow_v = 0; float gate_v = 0.f;
        if (COMBINE) { const int idx = row0 * 4 + (F.lane & 31); const int so = P_slot[idx]; gate_v = P_gate[idx]; orow_v = X[32 + (so >> 14)] * 256 + (so & 16383); }
#pragma unroll
        for (int r = 0; r < 8; ++r) {
            const int row = row0 + r;
            f32x4 xv[4];
#pragma unroll
            for (int j = 0; j < 4; ++j) xv[j] = *(const f32x4*)(xin + (size_t)row * D + 4 * F.lane + 256 * j);
            if (COMBINE) {
                u32x2 w[4][4]; float gt[4];
#pragma unroll
                for (int k = 0; k < TOPK; ++k) {
                    const size_t orow = (size_t)__builtin_amdgcn_readlane(orow_v, 4 * r + k); gt[k] = __builtin_bit_cast(float, __builtin_amdgcn_readlane(__builtin_bit_cast(int, gate_v), 4 * r + k));
#pragma unroll
                    for (int j = 0; j < 4; ++j) w[k][j] = *(const u32x2*)(P_OB + orow * D + 4 * F.lane + 256 * j);
                }
#pragma unroll
                for (int j = 0; j < 4; ++j) {
                    f32x4 y = (f32x4){0.f, 0.f, 0.f, 0.f};
#pragma unroll
                    for (int k = 0; k < TOPK; ++k) y += gt[k] * (f32x4){bflo(w[k][j].x), bfhi(w[k][j].x), bflo(w[k][j].y), bfhi(w[k][j].y)};
                    xv[j] += g2v[j] * y; *(f32x4*)(xout + (size_t)row * D + 4 * F.lane + 256 * j) = xv[j]; }
            }
            if (NORM) {
                float ss = 0.f;
#pragma unroll
                for (int j = 0; j < 4; ++j) ss += (xv[j][0] * xv[j][0] + xv[j][1] * xv[j][1]) + (xv[j][2] * xv[j][2] + xv[j][3] * xv[j][3]);
                const float rstd = __builtin_amdgcn_rsqf(wave_sum(ss) * (1.f / D) + EPS);
#pragma unroll
                for (int j = 0; j < 4; ++j) { const f32x4 h = xv[j] * rstd * a[j] + s[j]; u32x2 wv; wv.x = pk2(h[0], h[1]); wv.y = pk2(h[2], h[3]);
                    *(u32x2*)(xnout + (size_t)row * D + 4 * F.lane + 256 * j) = wv; }
            }
        }
    }
}

__device__ __forceinline__ void argmax_wave(float& v, int& e) {
#pragma unroll
    for (int o = 32; o >= 1; o >>= 1) { const float ov = __shfl_xor(v, o); const int oe = __shfl_xor(e, o); if (ov > v || (ov == v && oe < e)) { v = ov; e = oe; } }
}
__device__ __forceinline__ void phase_router(Frame& F, const Args& A, int l) {
    LAS f32x4* rw = (LAS f32x4*)F.lds;
    const bool probe = (A.opt & 8) != 0;
    unsigned char* xn8 = probe ? (A.ws + WS_H) : P_XN8; float* gout = probe ? (float*)(A.ws + WS_H + 32 * MiB) : P_gate; int* tokout = probe ? (int*)(A.ws + WS_H + 40 * MiB) : P_tok; int* slotout = probe ? (int*)(A.ws + WS_H + 48 * MiB) : P_slot;
    const int cbank = probe ? l + 8 : l;
    LAS int* X = (LAS int*)(F.lds + XTR_OFF);
    { const f32x4* src = (const f32x4*)(P_rwT + (size_t)l * NE * D); for (int i = F.tid; i < NE * D / 4; i += NWAVES * 64) rw[i] = src[i]; }
    if (F.tid < NE) X[F.tid] = 0;
    __syncthreads();
    for (int rb = F.vcu; rb < M / 64; rb += F.G) {
        const int row0 = rb * 64 + F.wave * 8, b = row0 / SEQ;
        f32x4 a[4], s[4];
#pragma unroll
        for (int j = 0; j < 4; ++j) { const int c = 4 * F.lane + 256 * j; const f32x4 g = *(const f32x4*)(P_norm2_g + (size_t)l * D + c); const float* mp = P_mod + ((size_t)l * NB + b) * MODW;
            a[j] = g * (*(const f32x4*)(mp + 4 * D + c) + 1.0f); s[j] = *(const f32x4*)(mp + 3 * D + c); }
        for (int pr = 0; pr < 4; ++pr) {
            f32x4 h[2][4];
#pragma unroll
            for (int r = 0; r < 2; ++r) {
                const int row = row0 + 2 * pr + r;
                float ss = 0.f;
#pragma unroll
                for (int j = 0; j < 4; ++j) { h[r][j] = *(const f32x4*)(P_out + (size_t)row * D + 4 * F.lane + 256 * j); ss += (h[r][j][0] * h[r][j][0] + h[r][j][1] * h[r][j][1]) + (h[r][j][2] * h[r][j][2] + h[r][j][3] * h[r][j][3]); }
                const float rstd = __builtin_amdgcn_rsqf(wave_sum(ss) * (1.f / D) + EPS);
#pragma unroll
                for (int j = 0; j < 4; ++j) { h[r][j] = h[r][j] * rstd * a[j] + s[j];
#if MOE_FP8
                    *(unsigned*)(xn8 + (size_t)row * D + 4 * F.lane + 256 * j) = pk4_fp8(h[r][j][0] * FP8_ACT_SCALE, h[r][j][1] * FP8_ACT_SCALE, h[r][j][2] * FP8_ACT_SCALE, h[r][j][3] * FP8_ACT_SCALE);
#else
                    u32x2 w; w.x = pk2(h[r][j][0], h[r][j][1]); w.y = pk2(h[r][j][2], h[r][j][3]);
                    *(u32x2*)(P_XN + (size_t)row * D + 4 * F.lane + 256 * j) = w;
#endif
                }
            }
            float t16[2][16];
            { const bool up32 = (F.lane & 32) != 0;
#pragma unroll
              for (int i = 0; i < 16; ++i) {
                float pl0 = 0.f, pl1 = 0.f, ph0 = 0.f, ph1 = 0.f;
#pragma unroll
                for (int j = 0; j < 4; ++j) { const f32x4 wl = rw[i * 256 + 64 * j + F.lane], wh = rw[(i + 16) * 256 + 64 * j + F.lane];
                    pl0 += (h[0][j][0] * wl[0] + h[0][j][1] * wl[1]) + (h[0][j][2] * wl[2] + h[0][j][3] * wl[3]);
                    pl1 += (h[1][j][0] * wl[0] + h[1][j][1] * wl[1]) + (h[1][j][2] * wl[2] + h[1][j][3] * wl[3]);
                    ph0 += (h[0][j][0] * wh[0] + h[0][j][1] * wh[1]) + (h[0][j][2] * wh[2] + h[0][j][3] * wh[3]);
                    ph1 += (h[1][j][0] * wh[0] + h[1][j][1] * wh[1]) + (h[1][j][2] * wh[2] + h[1][j][3] * wh[3]); }
                t16[0][i] = (up32 ? ph0 : pl0) + __shfl_xor(up32 ? pl0 : ph0, 32);
                t16[1][i] = (up32 ? ph1 : pl1) + __shfl_xor(up32 ? pl1 : ph1, 32);
                asm volatile("" ::: "memory"); __builtin_amdgcn_sched_barrier(0);
              } }
#pragma unroll
            for (int r = 0; r < 2; ++r) {
                float t8[8], t4[4], t2[2];
                { const bool up = (F.lane & 16) != 0;
#pragma unroll
                  for (int i = 0; i < 8; ++i) { const float lo = t16[r][i], hi = t16[r][i + 8]; t8[i] = (up ? hi : lo) + __shfl_xor(up ? lo : hi, 16); } }
                { const bool up = (F.lane & 8) != 0;
#pragma unroll
                  for (int i = 0; i < 4; ++i) { const float lo = t8[i], hi = t8[i + 4]; t4[i] = (up ? hi : lo) + __shfl_xor(up ? lo : hi, 8); } }
                { const bool up = (F.lane & 4) != 0;
#pragma unroll
                  for (int i = 0; i < 2; ++i) { const float lo = t4[i], hi = t4[i + 2]; t2[i] = (up ? hi : lo) + __shfl_xor(up ? lo : hi, 4); } }
                float v;
                { const bool up = (F.lane & 2) != 0; const float lo = t2[0], hi = t2[1]; v = (up ? hi : lo) + __shfl_xor(up ? lo : hi, 2); }
                v += __shfl_xor(v, 1);
                const int me = F.lane >> 1;
                v += P_router_b[l * NE + me];
                float tv[4]; int te[4]; float cv = v;
#pragma unroll
                for (int k = 0; k < 4; ++k) { float bv = cv; int be = me; argmax_wave(bv, be); tv[k] = bv; te[k] = be; if (me == be) cv = -3.0e38f; }
                const float e1 = __expf(tv[1] - tv[0]), e2 = __expf(tv[2] - tv[0]), e3 = __expf(tv[3] - tv[0]); const float inv = 1.0f / (1.0f + e1 + e2 + e3);
                if (F.lane < 4) {
                    const int my_e = F.lane == 0 ? te[0] : F.lane == 1 ? te[1] : F.lane == 2 ? te[2] : te[3];
                    const float my_g = (F.lane == 0 ? 1.0f : F.lane == 1 ? e1 : F.lane == 2 ? e2 : e3) * inv;
                    const int lr = __hip_atomic_fetch_add(&X[my_e], 1, __ATOMIC_RELAXED, __HIP_MEMORY_SCOPE_WORKGROUP);
                    const int rl = F.wave * 8 + 2 * pr + r;
                    X[64 + rl * 4 + F.lane] = my_e | (lr << 8);
                    gout[(size_t)(rb * 64 + rl) * 4 + F.lane] = my_g;
                }
            }
        }
        __syncthreads();
        if (F.tid < NE) X[32 + F.tid] = (int)__hip_atomic_fetch_add(F.ctl + CW_CNT + (32 * cbank + F.tid) * 64, (unsigned)X[F.tid], RLX_AGENT);
        __syncthreads();
        if (F.tid < 256) { const int rl = F.tid >> 2, sv = X[64 + F.tid], e = sv & 255, lr = sv >> 8, pos = X[32 + e] + lr, row = rb * 64 + rl;
            tokout[e * M + pos] = row; slotout[row * 4 + (F.tid & 3)] = (e << 14) | pos; }
        __syncthreads();
        if (F.tid < NE) X[F.tid] = 0;
        __syncthreads();
    }
}


__device__ __forceinline__ void phase_router_mfma(Frame& F, const Args& A, int l) {
    const bool probe = (A.opt & 8) != 0;
    unsigned char* xn8 = probe ? (A.ws + WS_H) : P_XN8; float* gout = probe ? (float*)(A.ws + WS_H + 32 * MiB) : P_gate; int* tokout = probe ? (int*)(A.ws + WS_H + 40 * MiB) : P_tok; int* slotout = probe ? (int*)(A.ws + WS_H + 48 * MiB) : P_slot;
    const int cbank = probe ? l + 8 : l;
    LAS int* X = (LAS int*)(F.lds + XTR_OFF);
    LAS f32x4* asl = (LAS f32x4*)(F.lds + XTR_OFF + 2048);
    LAS float* lg = (LAS float*)(F.lds + RING_OFF);
    LAS float* ssx = (LAS float*)(F.lds + RING_OFF + 20480);
    __syncthreads();
    if (F.tid < NE) X[F.tid] = 0;
    const int rr = F.lane & 15, kq = F.lane >> 4, tile = F.wave & 3, kh = F.wave >> 2;
    for (int rb = F.vcu; rb < M / 64; rb += F.G) {
        const int b = (rb * 64) / SEQ;
        { const float* mp = P_mod + ((size_t)l * NB + b) * MODW;
          if (F.tid < 256) { const int c = 4 * F.tid; asl[F.tid] = *(const f32x4*)(P_norm2_g + (size_t)l * D + c) * (*(const f32x4*)(mp + 4 * D + c) + 1.0f); }
          else { const int c = 4 * (F.tid - 256); asl[F.tid] = *(const f32x4*)(mp + 3 * D + c); } }
        const int row = rb * 64 + 16 * tile + rr;
        const float* xp = P_out + (size_t)row * D + 512 * kh + 8 * kq;
        f32x4 xv[16][2];
#pragma unroll
        for (int s = 0; s < 16; ++s) { xv[s][0] = *(const f32x4*)(xp + 32 * s); xv[s][1] = *(const f32x4*)(xp + 32 * s + 4); }
        float ss = 0.f;
#pragma unroll
        for (int s = 0; s < 16; ++s) { const f32x4 v0 = xv[s][0], v1 = xv[s][1];
            ss += (v0[0] * v0[0] + v0[1] * v0[1]) + (v0[2] * v0[2] + v0[3] * v0[3]) + (v1[0] * v1[0] + v1[1] * v1[1]) + (v1[2] * v1[2] + v1[3] * v1[3]); }
        ss += __shfl_xor(ss, 16); ss += __shfl_xor(ss, 32);
        if (kq == 0) ssx[(tile * 2 + kh) * 16 + rr] = ss;
        __syncthreads();
        const float rstd = __builtin_amdgcn_rsqf((ssx[(tile * 2) * 16 + rr] + ssx[(tile * 2 + 1) * 16 + rr]) * (1.f / D) + EPS);
        f32x4 acc[2]; acc[0] = (f32x4){0.f, 0.f, 0.f, 0.f}; acc[1] = (f32x4){0.f, 0.f, 0.f, 0.f};
        const bf16* wh = P_RWH + ((size_t)l * NE + rr) * D + 512 * kh + 8 * kq; const bf16* wl = P_RWL + ((size_t)l * NE + rr) * D + 512 * kh + 8 * kq;
        unsigned char* xo = xn8 + (size_t)row * D + 512 * kh + 8 * kq;
#pragma unroll
        for (int s = 0; s < 16; ++s) {
            const int ci = 128 * kh + 8 * s + 2 * kq;
            const f32x4 h0 = xv[s][0] * rstd * asl[ci] + asl[256 + ci], h1 = xv[s][1] * rstd * asl[ci + 1] + asl[256 + ci + 1];
            u32x2 q8; q8.x = pk4_fp8(h0[0] * FP8_ACT_SCALE, h0[1] * FP8_ACT_SCALE, h0[2] * FP8_ACT_SCALE, h0[3] * FP8_ACT_SCALE); q8.y = pk4_fp8(h1[0] * FP8_ACT_SCALE, h1[1] * FP8_ACT_SCALE, h1[2] * FP8_ACT_SCALE, h1[3] * FP8_ACT_SCALE);
            *(u32x2*)(xo + 32 * s) = q8;
            u32x4 hw; hw.x = cvt_pk_bf16(h0[0], h0[1]); hw.y = cvt_pk_bf16(h0[2], h0[3]); hw.z = cvt_pk_bf16(h1[0], h1[1]); hw.w = cvt_pk_bf16(h1[2], h1[3]);
            u32x4 lw; lw.x = cvt_pk_bf16(h0[0] - bflo(hw.x), h0[1] - bfhi(hw.x)); lw.y = cvt_pk_bf16(h0[2] - bflo(hw.y), h0[3] - bfhi(hw.y)); lw.z = cvt_pk_bf16(h1[0] - bflo(hw.z), h1[1] - bfhi(hw.z)); lw.w = cvt_pk_bf16(h1[2] - bflo(hw.w), h1[3] - bfhi(hw.w));
            const bf16x8 hf = __builtin_bit_cast(bf16x8, hw), lf = __builtin_bit_cast(bf16x8, lw);
#pragma unroll
            for (int hv = 0; hv < 2; ++hv) {
                const bf16x8 rh = *(const bf16x8*)(wh + (size_t)hv * 16 * D + 32 * s), rl = *(const bf16x8*)(wl + (size_t)hv * 16 * D + 32 * s);
                acc[hv] = __builtin_amdgcn_mfma_f32_16x16x32_bf16(rh, hf, acc[hv], 0, 0, 0);
                acc[hv] = __builtin_amdgcn_mfma_f32_16x16x32_bf16(rh, lf, acc[hv], 0, 0, 0);
                acc[hv] = __builtin_amdgcn_mfma_f32_16x16x32_bf16(rl, hf, acc[hv], 0, 0, 0);
            }
        }
        { LAS float* lgw = lg + (tile * 2 + kh) * (16 * 33);
#pragma unroll
          for (int hv = 0; hv < 2; ++hv)
#pragma unroll
            for (int i = 0; i < 4; ++i) lgw[rr * 33 + 16 * hv + 4 * kq + i] = acc[hv][i]; }
        __syncthreads();
        if (kh == 0 && F.lane < 16) {
            const LAS float* l0 = lg + (tile * 2) * (16 * 33) + F.lane * 33; const LAS float* l1 = l0 + 16 * 33;
            float v[32];
#pragma unroll
            for (int e = 0; e < 32; ++e) v[e] = (l0[e] + l1[e]) + P_router_b[l * NE + e];
            unsigned taken = 0u; float tv[4]; int te[4];
#pragma unroll
            for (int k = 0; k < 4; ++k) { float best = -3.0e38f; int bi = 0;
#pragma unroll
                for (int e = 0; e < 32; ++e) { const bool ok = ((taken >> e) & 1u) == 0u && v[e] > best; best = ok ? v[e] : best; bi = ok ? e : bi; }
                tv[k] = best; te[k] = bi; taken |= 1u << bi; }
            const float e1 = __expf(tv[1] - tv[0]), e2 = __expf(tv[2] - tv[0]), e3 = __expf(tv[3] - tv[0]); const float inv = 1.0f / (1.0f + e1 + e2 + e3);
            const int rl = 16 * tile + F.lane; const float gk[4] = {inv, e1 * inv, e2 * inv, e3 * inv};
#pragma unroll
            for (int k = 0; k < 4; ++k) { const int lr = __hip_atomic_fetch_add(&X[te[k]], 1, __ATOMIC_RELAXED, __HIP_MEMORY_SCOPE_WORKGROUP); X[64 + rl * 4 + k] = te[k] | (lr << 8); }
            *(f32x4*)(gout + (size_t)(rb * 64 + rl) * 4) = (f32x4){gk[0], gk[1], gk[2], gk[3]};
        }
        __syncthreads();
        if (F.tid < NE) X[32 + F.tid] = (int)__hip_atomic_fetch_add(F.ctl + CW_CNT + (32 * cbank + F.tid) * 64, (unsigned)X[F.tid], RLX_AGENT);
        __syncthreads();
        if (F.tid < 256) { const int rl = F.tid >> 2, sv = X[64 + F.tid], e = sv & 255, lr = sv >> 8, pos = X[32 + e] + lr, row2 = rb * 64 + rl;
            tokout[e * M + pos] = row2; slotout[row2 * 4 + (F.tid & 3)] = (e << 14) | pos; }
        __syncthreads();
        if (F.tid < NE) X[F.tid] = 0;
        __syncthreads();
    }
}

typedef float f32x16 __attribute__((ext_vector_type(16)));
typedef short s16x4 __attribute__((ext_vector_type(4)));
__device__ __forceinline__ s16x4 lds_tr16(LAS unsigned char* p) { return __builtin_bit_cast(s16x4, __builtin_amdgcn_ds_read_tr16_b64_v4i16((LAS s16x4*)p)); }
#define ATT_GLDS(gp, lp) __builtin_amdgcn_global_load_lds((const unsigned*)(gp), (LAS unsigned*)(lp), 16, 0, 0)
__device__ __forceinline__ void phase_attn(Frame& F, const Args& A, int l) {
    LAS unsigned char* wl = F.lds + F.wave * 16384;
    LAS float* bt = (LAS float*)(F.lds + XTR_OFF) + F.wave * 320;
    const int lane = F.lane, r = lane & 31, hh = lane >> 5;
    __syncthreads();
    unsigned koffE, koffO, voff0;
    { const int row = lane >> 3, cp = lane & 7, ck = cp ^ ((row >> 1) & 7), cv = cp ^ (4 * ((row >> 1) & 1));
      koffE = (unsigned)(row * INW * 2 + ck * 16); koffO = (unsigned)(row * INW * 2 + (ck ^ 4) * 16); voff0 = (unsigned)(row * INW * 2 + AW * 2 + cv * 16); }
    unsigned kaddr0;
    { const int cp = hh ^ ((r >> 1) & 7); kaddr0 = (unsigned)(r * 128 + cp * 16); }
    unsigned vaddr[2];
    { const int li = lane & 15, q4 = li >> 2, p4 = li & 3, g = (lane >> 4) & 1;
#pragma unroll
      for (int db = 0; db < 2; ++db) { const int cp = 4 * (db ^ (q4 >> 1)) + 2 * g + (p4 >> 1); vaddr[db] = (unsigned)(4096 + (4 * hh + q4) * 128 + cp * 16 + 8 * (p4 & 1)); } }
    for (int uw = F.vcu * NWAVES + F.wave; uw < NB * NH * NCH; uw += F.G * NWAVES) {
        const int bh = uw >> 6, n = uw & 63, b = bh >> 3, h = bh & 7;
        { float v[5]; float mb = -3.0e38f;
#pragma unroll
          for (int i = 0; i < 5; ++i) { const int idx = lane + 64 * i; v[i] = idx < 257 ? P_rel_bias[((size_t)l * NH + h) * 257 + idx] * LOG2E : -3.0e38f; mb = fmaxf(mb, v[i]); }
#pragma unroll
          for (int o = 1; o < 64; o <<= 1) mb = fmaxf(mb, __shfl_xor(mb, o));
#pragma unroll
          for (int i = 0; i < 5; ++i) { const int idx = lane + 64 * i; if (idx < 257) bt[idx] = v[i] - mb; } }
        LDS_WAIT(); asm volatile("" ::: "memory");
        const int jlo = n >= LEFTC ? n - LEFTC : 0, NT = 2 * (n - jlo + 1);
        const char* kb0 = (const char*)(P_QKVU + (size_t)(b * SEQ + CHUNK * jlo) * INW + AW + h * HD);
#define ATT_ISSUE(t) do { const char* kb_ = kb0 + (size_t)(t) * 32 * INW * 2; LAS unsigned char* lb_ = wl + ((t) & 1) * 8192; \
        _Pragma("unroll") for (int i_ = 0; i_ < 4; ++i_) ATT_GLDS(kb_ + (size_t)i_ * 8 * INW * 2 + ((i_ & 1) ? koffO : koffE), lb_ + i_ * 1024); \
        _Pragma("unroll") for (int i_ = 0; i_ < 4; ++i_) ATT_GLDS(kb_ + (size_t)i_ * 8 * INW * 2 + voff0, lb_ + 4096 + i_ * 1024); } while (0)
        ATT_ISSUE(0);
        bf16x8 qf[2][4];
        { const bf16* qp = P_QKVU + (size_t)(b * SEQ + CHUNK * n + r) * INW + h * HD + 8 * hh;
#pragma unroll
          for (int qb = 0; qb < 2; ++qb)
#pragma unroll
            for (int d0 = 0; d0 < 4; ++d0) qf[qb][d0] = *(const bf16x8*)(qp + (size_t)qb * 32 * INW + 16 * d0); }
        f32x16 o[2][2]; float lsum[2] = {0.f, 0.f};
#pragma unroll
        for (int qb = 0; qb < 2; ++qb)
#pragma unroll
            for (int db = 0; db < 2; ++db)
#pragma unroll
                for (int i = 0; i < 16; ++i) o[qb][db][i] = 0.f;
#pragma unroll 1
        for (int t = 0; t < NT; ++t) {
            if (t + 1 < NT) { ATT_ISSUE(t + 1); asm volatile("s_waitcnt vmcnt(8)" ::: "memory"); } else { asm volatile("s_waitcnt vmcnt(0)" ::: "memory"); }
            LAS unsigned char* tb = wl + (t & 1) * 8192;
            bf16x8 kf[4];
#pragma unroll
            for (int d0 = 0; d0 < 4; ++d0) kf[d0] = *(const LAS bf16x8*)(tb + (kaddr0 ^ (unsigned)(d0 << 5)));
            const int jj = jlo + (t >> 1) - (n - LEFTC), th = t & 1;
            bf16x8 pf[2][2];
#pragma unroll
            for (int qb = 0; qb < 2; ++qb) {
                f32x16 s;
                if (jj <= 5) { const float c0 = bt[0];
#pragma unroll
                    for (int i = 0; i < 16; ++i) s[i] = c0;
                } else {
                    const int relb = (jj - LEFTC) * CHUNK + 32 * th + 4 * hh - 32 * qb - r;
#pragma unroll
                    for (int i = 0; i < 16; ++i) { int rel = relb + (i & 3) + 8 * (i >> 2); rel = rel < -128 ? -128 : (rel > 128 ? 128 : rel); s[i] = bt[rel + 128]; }
                }
#pragma unroll
                for (int d0 = 0; d0 < 4; ++d0) s = __builtin_amdgcn_mfma_f32_32x32x16_bf16(kf[d0], qf[qb][d0], s, 0, 0, 0);
                float ls = 0.f;
#pragma unroll
                for (int i = 0; i < 16; ++i) { s[i] = __builtin_amdgcn_exp2f(s[i]); ls += s[i]; }
                lsum[qb] += ls;
#pragma unroll
                for (int st = 0; st < 2; ++st) { u32x4 w; w.x = cvt_pk_bf16(s[8 * st + 0], s[8 * st + 1]); w.y = cvt_pk_bf16(s[8 * st + 2], s[8 * st + 3]); w.z = cvt_pk_bf16(s[8 * st + 4], s[8 * st + 5]); w.w = cvt_pk_bf16(s[8 * st + 6], s[8 * st + 7]);
                    pf[qb][st] = __builtin_bit_cast(bf16x8, w); }
                __builtin_amdgcn_sched_barrier(0);
            }
#pragma unroll
            for (int db = 0; db < 2; ++db)
#pragma unroll
                for (int st = 0; st < 2; ++st) {
                    const s16x4 lo = lds_tr16(tb + vaddr[db] + st * 2048), hi = lds_tr16(tb + vaddr[db] + st * 2048 + 1024);
                    const bf16x8 vf = (bf16x8){lo[0], lo[1], lo[2], lo[3], hi[0], hi[1], hi[2], hi[3]};
#pragma unroll
                    for (int qb = 0; qb < 2; ++qb) o[qb][db] = __builtin_amdgcn_mfma_f32_32x32x16_bf16(vf, pf[qb][st], o[qb][db], 0, 0, 0);
                }
            LDS_WAIT(); asm volatile("" ::: "memory");
        }
#undef ATT_ISSUE
#pragma unroll
        for (int qb = 0; qb < 2; ++qb) {
            const float lt = lsum[qb] + __shfl_xor(lsum[qb], 32); const float il = 1.0f / lt;
            bf16* op = P_MIX + (size_t)(b * SEQ + CHUNK * n + 32 * qb + r) * D + h * HD + 4 * hh;
#pragma unroll
            for (int db = 0; db < 2; ++db)
#pragma unroll
                for (int g4 = 0; g4 < 4; ++g4) { u32x2 w; w.x = cvt_pk_bf16(o[qb][db][4 * g4 + 0] * il, o[qb][db][4 * g4 + 1] * il); w.y = cvt_pk_bf16(o[qb][db][4 * g4 + 2] * il, o[qb][db][4 * g4 + 3] * il);
                    *(u32x2*)(op + 32 * db + 8 * g4) = w; }
        }
    }
    __syncthreads();
}
template <int W>
__device__ __forceinline__ void pool_dtile(const bf16* up, int t0, LAS unsigned char* wl, int lane) {
    unsigned hist[W - 1], cur[32];
#pragma unroll
    for (int k = 0; k < W - 1; ++k) hist[k] = (t0 - (W - 1) + k >= 0) ? *(const unsigned*)(up - (size_t)(W - 1 - k) * INW) : 0u;
#pragma unroll
    for (int i = 0; i < 32; ++i) cur[i] = *(const unsigned*)(up + (size_t)i * INW);
    float s0 = 0.f, s1 = 0.f;
#pragma unroll
    for (int k = 0; k < W - 1; ++k) { s0 += bflo(hist[k]); s1 += bfhi(hist[k]); }
#pragma unroll
    for (int i = 0; i < 32; ++i) {
        const float u0 = bflo(cur[i]), u1 = bfhi(cur[i]);
        s0 += u0; s1 += u1;
        const int tp = t0 + i; const float ic = (tp + 1) < W ? 1.0f / (float)(tp + 1) : 1.0f / (float)W;
        *(LAS unsigned*)(wl + i * 256 + 4 * lane) = pk2(s0 * ic - u0, s1 * ic - u1);
        const unsigned vo = (i - W + 1 >= 0) ? cur[(i - W + 1 >= 0) ? (i - W + 1) : 0] : hist[(i < W - 1) ? i : 0];
        s0 -= bflo(vo); s1 -= bfhi(vo);
    }
}
__device__ __forceinline__ void phase_pool(Frame& F, const Args& A, int l) {
    LAS unsigned char* wl = F.lds + F.wave * 16384;
    const int lane = F.lane, r = lane & 31, hh = lane >> 5;
    __syncthreads();
    for (int uw = F.vcu * NWAVES + F.wave; uw < (M / 32) * 4; uw += F.G * NWAVES) {
        const int g = uw & 3, rb = uw >> 2, row0 = rb * 32, t0 = row0 % SEQ;
        const bf16* up = P_QKVU + (size_t)row0 * INW + 3 * AW + g * PGRP + 2 * lane;
        if (g == 0) pool_dtile<2>(up, t0, wl, lane); else if (g == 1) pool_dtile<4>(up, t0, wl, lane); else if (g == 2) pool_dtile<8>(up, t0, wl, lane); else pool_dtile<16>(up, t0, wl, lane);
        LDS_WAIT(); asm volatile("" ::: "memory");
        bf16x8 df[8];
#pragma unroll
        for (int st = 0; st < 8; ++st) df[st] = *(const LAS bf16x8*)(wl + r * 256 + 32 * st + 16 * hh);
        const bf16* wt = P_PWT + ((size_t)(l * 4 + g) * PGRP + r) * PGRP + 8 * hh;
        const float* pb = P_pool_b + l * 512 + g * PGRP + 4 * hh; const float* ps = P_pool_scale + l * 512 + g * PGRP + 4 * hh;
        bf16* op = P_MIX + (size_t)(row0 + r) * D + AW + g * PGRP + 4 * hh;
#pragma unroll 2
        for (int jb = 0; jb < 4; ++jb) {
            f32x16 acc;
#pragma unroll
            for (int i = 0; i < 16; ++i) acc[i] = 0.f;
#pragma unroll
            for (int st = 0; st < 8; ++st) { const bf16x8 wf = *(const bf16x8*)(wt + (size_t)jb * 32 * PGRP + 16 * st); acc = __builtin_amdgcn_mfma_f32_32x32x16_bf16(wf, df[st], acc, 0, 0, 0); }
#pragma unroll
            for (int g4 = 0; g4 < 4; ++g4) { const f32x4 bv = *(const f32x4*)(pb + 32 * jb + 8 * g4), sv = *(const f32x4*)(ps + 32 * jb + 8 * g4);
                u32x2 wv; wv.x = cvt_pk_bf16((acc[4 * g4 + 0] + bv[0]) * sv[0], (acc[4 * g4 + 1] + bv[1]) * sv[1]); wv.y = cvt_pk_bf16((acc[4 * g4 + 2] + bv[2]) * sv[2], (acc[4 * g4 + 3] + bv[3]) * sv[3]);
                *(u32x2*)(op + 32 * jb + 8 * g4) = wv; }
        }
        LDS_WAIT(); asm volatile("" ::: "memory");
    }
    __syncthreads();
}

__device__ __forceinline__ void phase_attn_naive(Frame& F, const Args& A, int l) {
    LAS unsigned char* kt = F.lds + F.wave * 16384;
    LAS float* bt = (LAS float*)(F.lds + XTR_OFF) + F.wave * 320;
    const int h = F.wave;
    __syncthreads();
    for (int i = F.lane; i < 257; i += 64) bt[i] = P_rel_bias[((size_t)l * NH + h) * 257 + i] * LOG2E;
    LDS_WAIT();
    const int hf = F.lane >> 5, d0 = 32 * hf;
    for (int un = F.vcu; un < NB * NCH; un += F.G) {
        const int b = un / NCH, n = un % NCH;
#pragma unroll 1
        for (int pass = 0; pass < 2; ++pass) {
            const int qi = 32 * pass + (F.lane & 31); const int qrow = b * SEQ + n * CHUNK + qi;
            float q[32], o[32];
            { const u32x4* qp = (const u32x4*)(P_QKVU + (size_t)qrow * INW + h * HD + d0);
#pragma unroll
              for (int c = 0; c < 4; ++c) { const u32x4 w = qp[c]; q[8 * c + 0] = bflo(w.x); q[8 * c + 1] = bfhi(w.x); q[8 * c + 2] = bflo(w.y); q[8 * c + 3] = bfhi(w.y); q[8 * c + 4] = bflo(w.z); q[8 * c + 5] = bfhi(w.z); q[8 * c + 6] = bflo(w.w); q[8 * c + 7] = bfhi(w.w); } }
#pragma unroll
            for (int d = 0; d < 32; ++d) o[d] = 0.f;
            float mrun = -1.0e30f, lrun = 0.f;
#pragma unroll 1
            for (int jj = (n >= LEFTC ? 0 : LEFTC - n); jj <= LEFTC; ++jj) {
                const int krow = b * SEQ + (n - LEFTC + jj) * CHUNK + F.lane;
                { const u32x4* kp = (const u32x4*)(P_QKVU + (size_t)krow * INW + AW + h * HD); const u32x4* vp = (const u32x4*)(P_QKVU + (size_t)krow * INW + 2 * AW + h * HD);
#pragma unroll
                  for (int c = 0; c < 8; ++c) { *(LAS u32x4*)(kt + F.lane * 128 + 16 * c) = kp[c]; *(LAS u32x4*)(kt + 8192 + F.lane * 128 + 16 * c) = vp[c]; } }
                LDS_WAIT(); asm volatile("" ::: "memory");
#pragma unroll 1
                for (int key = 0; key < 64; ++key) {
                    float acc = 0.f;
#pragma unroll
                    for (int c = 0; c < 4; ++c) { const u32x4 w = *(const LAS u32x4*)(kt + key * 128 + 2 * d0 + 16 * c);
                        acc += q[8 * c + 0] * bflo(w.x) + q[8 * c + 1] * bfhi(w.x) + q[8 * c + 2] * bflo(w.y) + q[8 * c + 3] * bfhi(w.y) + q[8 * c + 4] * bflo(w.z) + q[8 * c + 5] * bfhi(w.z) + q[8 * c + 6] * bflo(w.w) + q[8 * c + 7] * bfhi(w.w); }
                    acc += __shfl_xor(acc, 32);
                    int rel = (jj - LEFTC) * CHUNK + key - qi; rel = rel < -128 ? -128 : (rel > 128 ? 128 : rel);
                    const float sc = acc + bt[rel + 128];
                    const float mnew = fmaxf(mrun, sc), alpha = __builtin_amdgcn_exp2f(mrun - mnew), p = __builtin_amdgcn_exp2f(sc - mnew);
                    mrun = mnew; lrun = lrun * alpha + p;
#pragma unroll
                    for (int c = 0; c < 4; ++c) { const u32x4 w = *(const LAS u32x4*)(kt + 8192 + key * 128 + 2 * d0 + 16 * c);
                        o[8 * c + 0] = o[8 * c + 0] * alpha + p * bflo(w.x); o[8 * c + 1] = o[8 * c + 1] * alpha + p * bfhi(w.x); o[8 * c + 2] = o[8 * c + 2] * alpha + p * bflo(w.y); o[8 * c + 3] = o[8 * c + 3] * alpha + p * bfhi(w.y);
                        o[8 * c + 4] = o[8 * c + 4] * alpha + p * bflo(w.z); o[8 * c + 5] = o[8 * c + 5] * alpha + p * bfhi(w.z); o[8 * c + 6] = o[8 * c + 6] * alpha + p * bflo(w.w); o[8 * c + 7] = o[8 * c + 7] * alpha + p * bfhi(w.w); }
                }
                LDS_WAIT(); asm volatile("" ::: "memory");
            }
            const float il = 1.0f / lrun;
            { u32x4* op = (u32x4*)(P_MIX + (size_t)qrow * D + h * HD + d0);
#pragma unroll
              for (int c = 0; c < 4; ++c) { u32x4 w; w.x = pk2(o[8 * c + 0] * il, o[8 * c + 1] * il); w.y = pk2(o[8 * c + 2] * il, o[8 * c + 3] * il); w.z = pk2(o[8 * c + 4] * il, o[8 * c + 5] * il); w.w = pk2(o[8 * c + 6] * il, o[8 * c + 7] * il); op[c] = w; } }
        }
    }
    __syncthreads();
}
__device__ __forceinline__ void phase_pool_naive(Frame& F, const Args& A, int l) {
    LAS float* dl = (LAS float*)F.lds;
    __syncthreads();
    for (int un = F.vcu; un < (M / 64) * 4; un += F.G) {
        const int rb = un >> 2, g = un & 3, w = 2 << g;
        { const int c = F.tid & 127, r0 = F.tid >> 7;
          for (int i = 0; i < 16; ++i) { const int r = r0 + 4 * i, row = rb * 64 + r, tpos = row % SEQ; const int cnt = (tpos + 1) < w ? (tpos + 1) : w;
              float sum = 0.f; for (int s = 0; s < cnt; ++s) sum += bflo((unsigned)P_QKVU[(size_t)(row - s) * INW + 3 * AW + g * PGRP + c]);
              const float ut = bflo((unsigned)P_QKVU[(size_t)row * INW + 3 * AW + g * PGRP + c]);
              dl[r * 129 + c] = sum / (float)cnt - ut; } }
        __syncthreads();
        { const int j = F.tid & 127, rq = F.tid >> 7; float acc[16];
#pragma unroll
          for (int i = 0; i < 16; ++i) acc[i] = 0.f;
          const float* pw = P_pool_w + ((size_t)(l * 4 + g) * PGRP) * PGRP + j;
          for (int c = 0; c < PGRP; ++c) { const float wv = pw[(size_t)c * PGRP];
#pragma unroll
              for (int i = 0; i < 16; ++i) acc[i] += dl[(rq + 4 * i) * 129 + c] * wv; }
          const float pb = P_pool_b[l * 512 + g * PGRP + j], ps = P_pool_scale[l * 512 + g * PGRP + j];
#pragma unroll
          for (int i = 0; i < 16; ++i) P_MIX[(size_t)(rb * 64 + rq + 4 * i) * D + AW + g * PGRP + j] = (bf16)f2bf((acc[i] + pb) * ps); }
        __syncthreads();
    }
}

constexpr int NSTEP = 1 + 7 * DEPTH + 1;

__global__ void __launch_bounds__(NWAVES * 64, 2) mk_fwd(Args args) {
    const Args& A = args;
    extern __shared__ __attribute__((aligned(16))) unsigned char lds[];
    Frame F;
    F.lds = (LAS unsigned char*)lds;
    F.MISC = (volatile LAS unsigned*)(F.lds + LDSCTL_OFF);
    F.tid = threadIdx.x; F.lane = F.tid & 63; F.wave = __builtin_amdgcn_readfirstlane(F.tid >> 6);
    F.G = gridDim.x; { const int bx = blockIdx.x; F.vcu = (F.G % 8 == 0) ? (bx % 8) * (F.G / 8) + bx / 8 : bx; }
    unsigned char* ws = args.ws;
    F.ctl = (gu32*)(ws + WS_CTL);
    for (int u = F.tid; u < 128; u += NWAVES * 64) ((LAS unsigned*)(F.lds + LDSCTL_OFF))[u] = 0u;
    __syncthreads();
    XcdBarrier bar; bar.bar = (unsigned*)(F.ctl + CW_BAR + args.li * BAR_STRIDE); bar.x = 0; bar.st = nullptr;
#if MK_ONE_LAUNCH && PROBE_STEP < 0
    constexpr int lo = 0, hi = NSTEP;
#else
    const int lo = args.s_lo, hi = args.s_hi;
#endif
    if (hi - lo > 1) bar = xcd_barrier_post((unsigned*)(F.ctl + CW_BAR + args.li * BAR_STRIDE), F.MISC + 8);
#define IN(k) (lo <= (k) && (k) < hi)
#define OPAQUE() do { asm volatile("" : "+v"(F.tid)); F.lane = F.tid & 63; F.wave = __builtin_amdgcn_readfirstlane(F.tid >> 6); } while (0)
#define SEAM(k) do { if (IN(k) && IN((k) + 1)) { XcdBarrier b2_ = bar; asm volatile("" : "+s"(b2_.bar), "+s"(b2_.x)); xcd_barrier(b2_); } } while (0)

    if (IN(0)) { OPAQUE(); p0_mod(F, args); p0_convert(F, args); SEAM(0); }

    for (int l = 0; l < DEPTH; ++l) {
        const int sb = 1 + 7 * l;
        if (IN(sb + 0)) { OPAQUE(); if (l == 0) phase_cn<false, true>(F, args, l); else phase_cn<true, true>(F, args, l); SEAM(sb + 0); }
        if (IN(sb + 1)) { OPAQUE();
            pg8::DenseOrder S; S.init(M, INW, F.G, (int)blockIdx.x, P_XN, P_WIN + (size_t)l * INW * D);
            pg8::EpiWin E{P_QKVU, P_q_g + l * HD, P_k_g + l * HD};
            pg8::gemm_phase<pg8::EpiWin, pg8::DenseOrder, true>(F.lds + RING_OFF, S, E);
            SEAM(sb + 1);
        }
        if (IN(sb + 2)) {
#if ATTN_NAIVE
            OPAQUE(); phase_attn_naive(F, args, l);
#else
            if (!(args.opt & 2)) { OPAQUE(); phase_attn(F, args, l); }
#endif
#if POOL_NAIVE
            OPAQUE(); phase_pool_naive(F, args, l);
#else
            if (!(args.opt & 1)) { OPAQUE(); phase_pool(F, args, l); }
#endif
            SEAM(sb + 2); }
        if (IN(sb + 3)) { OPAQUE();
            pg8::DenseOrder S; S.init(M, D, F.G, (int)blockIdx.x, P_MIX, P_WOUT + (size_t)l * D * D);
            pg8::EpiWout E{l == 0 ? P_x : P_out, P_out, P_mod + (size_t)l * NB * MODW + 2 * D};
            pg8::gemm_phase<pg8::EpiWout, pg8::DenseOrder, true>(F.lds + RING_OFF, S, E);
            SEAM(sb + 3);
        }
        if (IN(sb + 4)) { OPAQUE();
#if ROUTER_VALU
            phase_router(F, args, l);
#else
            phase_router_mfma(F, args, l);
#endif
            SEAM(sb + 4); }
        if (IN(sb + 5)) { OPAQUE();
            const int T = moe_tables(F, l);
            LAS int* X = (LAS int*)(F.lds + XTR_OFF);
            pg8::MoeOrder<true, MOE_FP8 ? 1 : 2> S; S.tile_e = X + 128; S.toff = (const LAS unsigned*)(X + 512); S.T = T; S.vcu = F.vcu; S.G = F.G; S.ncol = 8; S.rpb = 4;
#if MOE_FP8
            constexpr int MEB = 1; S.A = (const char*)P_XN8; S.B = (const char*)(P_W18 + (size_t)l * NE * 2048 * D);
#else
            constexpr int MEB = 2; S.A = (const char*)P_XN; S.B = (const char*)(P_W1 + (size_t)l * NE * 2048 * D);
#endif
            S.estride = (size_t)2048 * D * MEB; S.tstep = (size_t)256 * D * MEB;
            { pg8::GUnit u; for (int i = 0; i < MAXU && S.next(i, u); ++i) { if (F.tid < 256) { const int e = u.e, base = u.row0 - X[32 + e] * 256 + F.tid, cnt = X[e]; const int idx = base < cnt ? base : cnt - 1;
                    ((LAS unsigned*)(X + 512))[i * 256 + F.tid] = (unsigned)P_tok[e * M + idx] * (unsigned)(D * MEB); } } }
            __syncthreads();
            pg8::EpiSwiglu E{P_H, P_exp_b1 + (size_t)l * NE * 2048};
            pg8::gemm_phase<pg8::EpiSwiglu, pg8::MoeOrder<true, MEB>, true, MEB>(F.lds + RING_OFF, S, E);
            SEAM(sb + 5);
        }
        if (IN(sb + 6)) { OPAQUE();
            const int T = moe_tables(F, l);
            LAS int* X = (LAS int*)(F.lds + XTR_OFF);
            pg8::MoeOrder<false, MOE_FP8 ? 1 : 2> S; S.tile_e = X + 128; S.toff = (const LAS unsigned*)(X + 512); S.T = T; S.vcu = F.vcu; S.G = F.G; S.ncol = 4; S.rpb = 8;
#if MOE_FP8
            constexpr int MEB = 1; S.A = (const char*)P_H8; S.B = (const char*)(P_W28 + (size_t)l * NE * D * FE);
#else
            constexpr int MEB = 2; S.A = (const char*)P_H; S.B = (const char*)(P_W2 + (size_t)l * NE * D * FE);
#endif
            S.estride = (size_t)D * FE * MEB; S.tstep = (size_t)256 * D * MEB;
            pg8::EpiOB E{P_OB, P_exp_b2 + (size_t)l * NE * D};
            pg8::gemm_phase<pg8::EpiOB, pg8::MoeOrder<false, MEB>, true, MEB>(F.lds + RING_OFF, S, E);
            SEAM(sb + 6);
        }
    }
    if (IN(NSTEP - 1)) { OPAQUE(); phase_cn<true, false>(F, args, DEPTH); }
#undef IN
#undef OPAQUE
#undef SEAM
}

extern "C" void kernel_launch(void* const* d_in, const int* in_sizes, int n_in, void* d_out, int out_size, void* d_ws, size_t ws_size, hipStream_t stream) {
    static int grid = 0;
    if (grid == 0) {
        if (n_in != 20 || in_sizes[0] != M * D || out_size != M * D || ws_size < WS_END) { fprintf(stderr, "kernel_launch: unexpected shapes / workspace (n_in %d, ws %zu)\n", n_in, ws_size); grid = -1; return; }
        int dev = 0, cus = 0, per_cu = 0;
        if (hipGetDevice(&dev) != hipSuccess || hipDeviceGetAttribute(&cus, hipDeviceAttributeMultiprocessorCount, dev) != hipSuccess) { grid = -1; return; }
        if (hipFuncSetAttribute((const void*)mk_fwd, hipFuncAttributeMaxDynamicSharedMemorySize, LDS_BYTES) != hipSuccess) { fprintf(stderr, "kernel_launch: hipFuncSetAttribute failed\n"); grid = -1; return; }
        if (hipOccupancyMaxActiveBlocksPerMultiprocessor(&per_cu, (const void*)mk_fwd, NWAVES * 64, LDS_BYTES) != hipSuccess || per_cu < 1) fprintf(stderr, "kernel_launch: occupancy query reports %d\n", per_cu);
        (void)hipGetLastError();
        grid = cus;
    }
    if (grid < 0) return;
    if (hipMemsetAsync((char*)d_ws + WS_CTL, 0, CTL_ZERO_BYTES, stream) != hipSuccess) return;
    Args a{};
    for (int i = 0; i < 20; ++i) a.in[i] = (const float*)d_in[i];
    a.out = (float*)d_out; a.ws = (unsigned char*)d_ws;
#if PROBE_STEP >= 0
    { int cuts[16]; int nc = 0; cuts[nc++] = 0;
      if (PROBE_STEP == 100) { cuts[nc++] = 1; } else { for (int l = 0; l < DEPTH; ++l) cuts[nc++] = 1 + 7 * l + PROBE_STEP + 1; }
      cuts[nc++] = NSTEP;
      for (int i = 0; i + 1 < nc; ++i) {
          a.s_lo = cuts[i]; a.s_hi = cuts[i + 1]; a.li = i; hipLaunchKernelGGL(mk_fwd, dim3(grid), dim3(NWAVES * 64), LDS_BYTES, stream, a);
          if (i + 2 < nc) { a.s_lo = cuts[i + 1] - 1; a.s_hi = cuts[i + 1]; a.opt = PROBE_OPT; hipLaunchKernelGGL(mk_fwd, dim3(grid), dim3(NWAVES * 64), LDS_BYTES, stream, a); a.opt = 0; }
      } }
#elif MK_ONE_LAUNCH
    a.s_lo = 0; a.s_hi = NSTEP;
    hipLaunchKernelGGL(mk_fwd, dim3(grid), dim3(NWAVES * 64), LDS_BYTES, stream, a);
#else
    for (int s = 0; s < NSTEP; ++s) { a.s_lo = s; a.s_hi = s + 1; hipLaunchKernelGGL(mk_fwd, dim3(grid), dim3(NWAVES * 64), LDS_BYTES, stream, a); }
#endif
}
```
